# Optimizing an MI355X kernel written in HIP

```python
import math
import jax, jax.numpy as jnp
from jax import lax
import numpy as np

D_MODEL = 1024
BATCH = 8
SEQ = 2048
DEPTH = 4
DEC_BATCH = 128
DEC_SEQ = 8
PAST_LEN = 16384
PAGE_SIZE = 128

A_HEADS = 4
A_KEY = 128
A_VAL = 128
B_HEADS = 4
B_QK = 64
B_VAL = 128
C_HEADS = 4
C_KEY = 128
C_VAL = 128
CONV_W = 4
CONV_CH = C_HEADS * (2 * C_KEY + C_VAL)
N_BRANCH = 3
BRANCH_W = 512
FFN_HIDDEN = -(-(8 * D_MODEL) // (3 * 256)) * 256
CHUNK = 64
ALPHA = (2 * DEPTH) ** 0.25
BETA_INIT = (8 * DEPTH) ** -0.25
LN_EPS = 1e-5
NORM_EPS = 1e-6
NEG_BIG = -1e30

SPLITS = (A_HEADS * A_KEY, A_HEADS * A_KEY, A_HEADS * A_VAL, A_HEADS * A_VAL,
          B_HEADS * B_QK, B_HEADS * B_QK, B_HEADS * B_VAL, B_HEADS * B_VAL, B_HEADS, B_HEADS,
          CONV_CH, C_HEADS * C_VAL, C_HEADS, C_HEADS,
          N_BRANCH * D_MODEL)
N_IN = sum(SPLITS)
SPLIT_IDX = tuple(int(v) for v in np.cumsum(SPLITS)[:-1])

kernel_name = 'hybrid_hgrn2_mlstm_gdn_step'


def _layer_norm(x, g, b):
    mu = jnp.mean(x, -1, keepdims=True)
    xc = x - mu
    var = jnp.mean(xc * xc, -1, keepdims=True)
    return xc * lax.rsqrt(var + LN_EPS) * g.astype(jnp.float32) + b.astype(jnp.float32)


def _heads(t, h):
    B, L, _ = t.shape
    return t.reshape(B, L, h, -1).transpose(0, 2, 1, 3)


def _head_rms_merge(o, g):
    o = o * lax.rsqrt(jnp.mean(o * o, -1, keepdims=True) + NORM_EPS)
    B, H, L, d = o.shape
    return o.transpose(0, 2, 1, 3).reshape(B, L, H * d) * g.astype(jnp.float32)


def _l2norm(t):
    return t * lax.rsqrt(jnp.sum(t * t, -1, keepdims=True) + NORM_EPS)


def _masked_exp(mask, t):
    return jnp.where(mask, jnp.exp(jnp.where(mask, t, 0.0)), 0.0)


def _chunk(t, c):
    B, H, L = t.shape[:3]
    t = t.reshape((B, H, L // c, c) + t.shape[3:])
    return jnp.moveaxis(t, 2, 0)


def _unchunk(o):
    n, B, H, c = o.shape[:4]
    o = jnp.moveaxis(o, 0, 2)
    return o.reshape((B, H, n * c) + o.shape[4:])


def _hgrn2_scan(q, k, v, logf, S0):
    c = math.gcd(q.shape[2], CHUNK)
    incl = jnp.tril(jnp.ones((c, c), bool))

    def step(S, blk):
        qc, kc, vc, fc = blk
        b = jnp.cumsum(fc, axis=2)
        diff = b[:, :, :, None, :] - b[:, :, None, :, :]
        dec = _masked_exp(incl[:, :, None], diff)
        att = jnp.einsum('bhtk,bhsk,bhtsk->bhts', qc, kc, dec)
        o = jnp.einsum('bhtk,bhkv->bhtv', qc * jnp.exp(b), S) + jnp.einsum('bhts,bhsv->bhtv', att, vc)
        bl = b[:, :, -1, :]
        S_new = jnp.exp(bl)[..., None] * S + jnp.einsum('bhsk,bhsv->bhkv', kc * jnp.exp(bl[:, :, None, :] - b), vc)
        return S_new, o

    S, o = lax.scan(step, S0, (_chunk(q, c), _chunk(k, c), _chunk(v, c), _chunk(logf, c)))
    return _unchunk(o), S


def _mlstm_scan(q, k, v, ig, lf, C0, n0, m0):
    c = math.gcd(q.shape[2], CHUNK)
    incl = jnp.tril(jnp.ones((c, c), bool))

    def step(carry, blk):
        Cm, n, m = carry
        qc, kc, vc, ic, fc = blk
        b = jnp.cumsum(fc, axis=-1)
        logd = jnp.where(incl, b[..., :, None] - b[..., None, :] + ic[..., None, :], NEG_BIG)
        m_inter = b + m[..., None]
        m_t = jnp.maximum(m_inter, jnp.max(logd, -1))
        w_inter = jnp.exp(m_inter - m_t)
        sc = jnp.einsum('bhtk,bhsk->bhts', qc, kc) * _masked_exp(incl, logd - m_t[..., None])
        num = w_inter[..., None] * jnp.einsum('bhvk,bhtk->bhtv', Cm, qc) + jnp.einsum('bhts,bhsv->bhtv', sc, vc)
        den = w_inter * jnp.einsum('bhk,bhtk->bht', n, qc) + jnp.sum(sc, -1)
        h = num / jnp.maximum(jnp.abs(den), jnp.exp(-m_t))[..., None]
        g = b[..., -1:] - b + ic
        m_new = jnp.maximum(b[..., -1] + m, jnp.max(g, -1))
        w_old = jnp.exp(b[..., -1] + m - m_new)
        wk = jnp.exp(g - m_new[..., None])
        C_new = w_old[..., None, None] * Cm + jnp.einsum('bhs,bhsv,bhsk->bhvk', wk, vc, kc)
        n_new = w_old[..., None] * n + jnp.einsum('bhs,bhsk->bhk', wk, kc)
        return (C_new, n_new, m_new), h

    (Cm, n, m), o = lax.scan(step, (C0, n0, m0),
                             (_chunk(q, c), _chunk(k, c), _chunk(v, c), _chunk(ig, c), _chunk(lf, c)))
    return _unchunk(o), Cm, n, m


def _gdn_scan(q, k, v, beta, g, S0):
    c = math.gcd(q.shape[2], CHUNK)
    strict = jnp.tril(jnp.ones((c, c), bool), -1)
    incl = jnp.tril(jnp.ones((c, c), bool))
    eye = jnp.eye(c, dtype=jnp.float32)
    dv = v.shape[-1]

    def step(S, blk):
        qc, kc, vc, bc, gc = blk
        b = jnp.cumsum(gc, axis=-1)
        diff = b[..., :, None] - b[..., None, :]
        a = bc[..., :, None] * jnp.einsum('bhtk,bhsk->bhts', kc, kc) * _masked_exp(strict, diff)
        rhs = jnp.concatenate([vc * bc[..., None], kc * (bc * jnp.exp(b))[..., None]], axis=-1)
        sol = lax.linalg.triangular_solve(eye + a, rhs, left_side=True, lower=True, unit_diagonal=True)
        v_new = sol[..., :dv] - jnp.einsum('bhtk,bhkv->bhtv', sol[..., dv:], S)
        att = jnp.einsum('bhtk,bhsk->bhts', qc, kc) * _masked_exp(incl, diff)
        o = jnp.einsum('bhtk,bhkv->bhtv', qc * jnp.exp(b)[..., None], S) + jnp.einsum('bhts,bhsv->bhtv', att, v_new)
        bl = b[..., -1]
        S_new = jnp.exp(bl)[..., None, None] * S + jnp.einsum('bhsk,bhsv->bhkv', kc * jnp.exp(bl[..., None] - b)[..., None], v_new)
        return S_new, o

    S, o = lax.scan(step, S0, (_chunk(q, c), _chunk(k, c), _chunk(v, c), _chunk(beta, c), _chunk(g, c)))
    return _unchunk(o), S


def _causal_conv(xc, buf, w):
    L = xc.shape[1]
    xp = jnp.concatenate([buf, xc], axis=1)
    out = xp[:, 0:L] * w[0]
    for j in range(1, CONV_W):
        out = out + xp[:, j:j + L] * w[j]
    return out, xp[:, L:]


def _trunk(x, st_a, st_c, st_n, st_m, st_g, st_conv,
           w_in, lb_logits, a_norm_g, b_mi, b_mf, b_norm_g, conv_w, a_log, dt_bias, c_norm_g,
           w_branch, w_out, ln1_g, ln1_b, w_ffn_in, w_ffn_out, ln2_g, ln2_b):
    f32 = jnp.float32
    dt = x.dtype
    B, L, _ = x.shape
    lb_w = jax.nn.softmax(lb_logits.astype(f32), axis=0)
    lb_all = jnp.cumsum(lb_w, axis=0) - lb_w[0]
    na, nc, nn, nm, ng, nv = [], [], [], [], [], []
    h = x
    for l in range(DEPTH):
        proj = jnp.einsum('bld,dn->bln', h, w_in[l])
        (aq, af, ai, ag, bq, bk, bv, bo, bi, bf, cx, cg, cb, ca, mg) = jnp.split(proj, SPLIT_IDX, axis=-1)

        lb = lb_all[l]
        af32 = af.astype(f32)
        a_logf = jnp.log(lb + (1.0 - lb) * jax.nn.sigmoid(af32))
        a_k = (1.0 - lb) * jax.nn.sigmoid(-af32)
        a_o, a_S = _hgrn2_scan(_heads(jax.nn.silu(aq.astype(f32)), A_HEADS), _heads(a_k, A_HEADS),
                               _heads(ai.astype(f32), A_HEADS), _heads(a_logf, A_HEADS), st_a[l].astype(f32))
        y_a = _head_rms_merge(a_o, a_norm_g[l]) * jax.nn.silu(ag.astype(f32))

        b_ig = (bi.astype(f32) + b_mi[l].astype(f32)).transpose(0, 2, 1)
        b_lf = jax.nn.log_sigmoid(bf.astype(f32) + b_mf[l].astype(f32)).transpose(0, 2, 1)
        b_o, b_C, b_n, b_m = _mlstm_scan(_heads(bq.astype(f32), B_HEADS) * B_QK ** -0.5,
                                         _heads(bk.astype(f32), B_HEADS), _heads(bv.astype(f32), B_HEADS),
                                         b_ig, b_lf, st_c[l].astype(f32), st_n[l].astype(f32), st_m[l].astype(f32))
        y_b = _head_rms_merge(b_o, b_norm_g[l]) * jax.nn.sigmoid(bo.astype(f32))

        cconv, cbuf = _causal_conv(cx.astype(f32), st_conv[l].astype(f32), conv_w[l].astype(f32))
        cconv = jax.nn.silu(cconv)
        cq, ck, cv = jnp.split(cconv, [C_HEADS * C_KEY, 2 * C_HEADS * C_KEY], axis=-1)
        cq = _l2norm(_heads(cq, C_HEADS)) * C_KEY ** -0.5
        ck = _l2norm(_heads(ck, C_HEADS))
        c_beta = jax.nn.sigmoid(cb.astype(f32)).transpose(0, 2, 1)
        c_g = (-jnp.exp(a_log[l].astype(f32)) * jax.nn.softplus(ca.astype(f32) + dt_bias[l].astype(f32))).transpose(0, 2, 1)
        c_o, c_S = _gdn_scan(cq, ck, _heads(cv, C_HEADS), c_beta, c_g, st_g[l].astype(f32))
        y_c = _head_rms_merge(c_o, c_norm_g[l]) * jax.nn.silu(cg.astype(f32))

        ys = jnp.stack([y_a, y_b, y_c], axis=2).astype(dt)
        z = jnp.einsum('blnc,ncd->blnd', ys, w_branch[l])
        gates = jax.nn.sigmoid(mg.reshape(B, L, N_BRANCH, D_MODEL).astype(f32))
        merged = jnp.sum(gates * z.astype(f32), axis=2).astype(dt)
        mix = merged @ w_out[l]
        h = _layer_norm(ALPHA * h.astype(f32) + mix.astype(f32), ln1_g[l], ln1_b[l]).astype(dt)

        gate, up = jnp.split(h @ w_ffn_in[l], 2, axis=-1)
        ff = (jax.nn.silu(gate) * up) @ w_ffn_out[l]
        h = _layer_norm(ALPHA * h.astype(f32) + ff.astype(f32), ln2_g[l], ln2_b[l]).astype(dt)

        na.append(a_S); nc.append(b_C); nn.append(b_n); nm.append(b_m); ng.append(c_S); nv.append(cbuf)
    return (h, jnp.stack(na), jnp.stack(nc), jnp.stack(nn), jnp.stack(nm), jnp.stack(ng), jnp.stack(nv))


def setup_inputs(seed: int = 0) -> dict:
    key = jax.random.key(seed)
    ks = jax.random.split(key, 32)
    f32 = jnp.float32

    def nrm(k, shape, s):
        return s * jax.random.normal(k, shape, f32)

    dt0 = jnp.exp(jax.random.uniform(ks[14], (DEPTH, C_HEADS), f32, math.log(1e-3), math.log(1e-1)))
    return {
        'x_prompt': nrm(ks[0], (BATCH, SEQ, D_MODEL), 1.0),
        'x_sample': nrm(ks[1], (DEC_BATCH, DEC_SEQ, D_MODEL), 1.0),
        'state_hgrn': nrm(ks[2], (DEPTH, DEC_BATCH, A_HEADS, A_KEY, A_VAL), 0.5),
        'state_mlstm_c': nrm(ks[3], (DEPTH, DEC_BATCH, B_HEADS, B_VAL, B_QK), 0.3),
        'state_mlstm_n': nrm(ks[4], (DEPTH, DEC_BATCH, B_HEADS, B_QK), 0.3),
        'state_mlstm_m': 1.0 + nrm(ks[5], (DEPTH, DEC_BATCH, B_HEADS), 0.5),
        'state_gdn': nrm(ks[6], (DEPTH, DEC_BATCH, C_HEADS, C_KEY, C_VAL), 0.2),
        'state_gdn_conv': nrm(ks[7], (DEPTH, DEC_BATCH, CONV_W - 1, CONV_CH), 1.0),
        'w_in': nrm(ks[8], (DEPTH, D_MODEL, N_IN), D_MODEL ** -0.5),
        'lb_logits': nrm(ks[9], (DEPTH, A_HEADS * A_KEY), 0.5),
        'a_norm_g': 1.0 + nrm(ks[10], (DEPTH, A_HEADS * A_VAL), 0.02),
        'b_mi': nrm(ks[11], (DEPTH, B_HEADS), 0.1),
        'b_mf': jnp.linspace(3.0, 6.0, B_HEADS, dtype=f32)[None, :] + nrm(ks[12], (DEPTH, B_HEADS), 0.1),
        'b_norm_g': 1.0 + nrm(ks[13], (DEPTH, B_HEADS * B_VAL), 0.02),
        'conv_w': nrm(ks[15], (DEPTH, CONV_W, CONV_CH), CONV_W ** -0.5),
        'a_log': jnp.log(jax.random.uniform(ks[16], (DEPTH, C_HEADS), f32, 1.0, 16.0)),
        'dt_bias': dt0 + jnp.log(-jnp.expm1(-dt0)),
        'c_norm_g': 1.0 + nrm(ks[17], (DEPTH, C_HEADS * C_VAL), 0.02),
        'w_branch': nrm(ks[18], (DEPTH, N_BRANCH, BRANCH_W, D_MODEL), BRANCH_W ** -0.5),
        'w_out': nrm(ks[19], (DEPTH, D_MODEL, D_MODEL), BETA_INIT * D_MODEL ** -0.5),
        'ln1_g': 1.0 + nrm(ks[20], (DEPTH, D_MODEL), 0.02),
        'ln1_b': nrm(ks[21], (DEPTH, D_MODEL), 0.02),
        'w_ffn_in': nrm(ks[22], (DEPTH, D_MODEL, 2 * FFN_HIDDEN), D_MODEL ** -0.5),
        'w_ffn_out': nrm(ks[23], (DEPTH, FFN_HIDDEN, D_MODEL), BETA_INIT * FFN_HIDDEN ** -0.5),
        'ln2_g': 1.0 + nrm(ks[24], (DEPTH, D_MODEL), 0.02),
        'ln2_b': nrm(ks[25], (DEPTH, D_MODEL), 0.02),
    }


def reference(x_prompt, x_sample, state_hgrn, state_mlstm_c, state_mlstm_n, state_mlstm_m, state_gdn,
              state_gdn_conv, w_in, lb_logits, a_norm_g, b_mi, b_mf, b_norm_g, conv_w, a_log, dt_bias,
              c_norm_g, w_branch, w_out, ln1_g, ln1_b, w_ffn_in, w_ffn_out, ln2_g, ln2_b):
    weights = (w_in, lb_logits, a_norm_g, b_mi, b_mf, b_norm_g, conv_w, a_log, dt_bias, c_norm_g,
               w_branch, w_out, ln1_g, ln1_b, w_ffn_in, w_ffn_out, ln2_g, ln2_b)
    f32 = jnp.float32
    Bp = x_prompt.shape[0]
    y_p, pa, pc, pn, pm, pg, pv = _trunk(
        x_prompt,
        jnp.zeros((DEPTH, Bp, A_HEADS, A_KEY, A_VAL), f32),
        jnp.zeros((DEPTH, Bp, B_HEADS, B_VAL, B_QK), f32),
        jnp.zeros((DEPTH, Bp, B_HEADS, B_QK), f32),
        jnp.zeros((DEPTH, Bp, B_HEADS), f32),
        jnp.zeros((DEPTH, Bp, C_HEADS, C_KEY, C_VAL), f32),
        jnp.zeros((DEPTH, Bp, CONV_W - 1, CONV_CH), f32),
        *weights)
    y_s, sa, sc, sn, sm, sg, sv = _trunk(
        x_sample, state_hgrn, state_mlstm_c, state_mlstm_n, state_mlstm_m, state_gdn, state_gdn_conv, *weights)
    return (y_p, y_s,
            pa.astype(state_hgrn.dtype), sa.astype(state_hgrn.dtype),
            pc.astype(state_mlstm_c.dtype), sc.astype(state_mlstm_c.dtype),
            pn.astype(state_mlstm_n.dtype), sn.astype(state_mlstm_n.dtype),
            pm.astype(state_mlstm_m.dtype), sm.astype(state_mlstm_m.dtype),
            pg.astype(state_gdn.dtype), sg.astype(state_gdn.dtype),
            pv.astype(state_gdn_conv.dtype), sv.astype(state_gdn_conv.dtype))
```

```cpp
#include <hip/hip_runtime.h>
#include <hip/hip_cooperative_groups.h>
#include <cstdio>
namespace cg = cooperative_groups;

#ifndef N_LAUNCH_MODE
#define N_LAUNCH_MODE 1
#endif

#define LAS __attribute__((address_space(3)))
typedef _Float16 h16;
typedef _Float16 h16x8 __attribute__((ext_vector_type(8)));
typedef _Float16 h16x4 __attribute__((ext_vector_type(4)));
typedef _Float16 h16x2 __attribute__((ext_vector_type(2)));
typedef float f32x4 __attribute__((ext_vector_type(4)));
typedef float f32x2 __attribute__((ext_vector_type(2)));

constexpr int DM = 1024, TP = 16384, TS = 1024, T = TP + TS, DEPTH = 4;
constexpr int NSRC_IN = 8720, NPROJ = 8960, FFH = 2816;
constexpr int NTHREADS = 512, NWAVES = 8;
constexpr float ALPHA = 1.681792830507429f;
constexpr int C_AQ = 0, C_AF = 512, C_AI = 1024, C_AG = 1536, C_BQ = 2048, C_BK = 2304, C_BV = 2560, C_BO = 3072, C_CX = 3584, C_CG = 5120, C_MG = 5632, C_SM = 8704;

constexpr size_t SZ_WIN = (size_t)DEPTH * NPROJ * DM * 2, SZ_WBR = (size_t)DEPTH * 3072 * 512 * 2, SZ_WOUT = (size_t)DEPTH * DM * DM * 2,
                 SZ_WF1 = (size_t)DEPTH * 2 * FFH * DM * 2, SZ_WF2 = (size_t)DEPTH * DM * FFH * 2, SZ_LB = DEPTH * 512 * 4;
constexpr size_t WS_WIN = 0, WS_WBR = WS_WIN + SZ_WIN, WS_WOUT = WS_WBR + SZ_WBR, WS_WF1 = WS_WOUT + SZ_WOUT, WS_WF2 = WS_WF1 + SZ_WF1, WS_LB = WS_WF2 + SZ_WF2;
constexpr size_t WS_H32 = WS_LB + SZ_LB, WS_P = WS_H32 + (size_t)T * DM * 4, WS_G = WS_P + (size_t)T * NPROJ * 2, WS_R1 = WS_G + (size_t)T * 16 * 4,
                 WS_R2 = WS_R1 + (size_t)T * 1536 * 2, WS_END = WS_R2 + (size_t)T * 1536 * 4;
constexpr size_t O_Y = 0, O_HA_P = (size_t)T * DM, O_HA_S = O_HA_P + (size_t)DEPTH * 8 * 4 * 16384, O_MC_P = O_HA_S + (size_t)DEPTH * 128 * 4 * 16384,
                 O_MC_S = O_MC_P + (size_t)DEPTH * 8 * 4 * 8192, O_MN_P = O_MC_S + (size_t)DEPTH * 128 * 4 * 8192, O_MN_S = O_MN_P + DEPTH * 8 * 4 * 64,
                 O_MM_P = O_MN_S + DEPTH * 128 * 4 * 64, O_MM_S = O_MM_P + DEPTH * 8 * 4, O_G_P = O_MM_S + DEPTH * 128 * 4, O_G_S = O_G_P + (size_t)DEPTH * 8 * 4 * 16384,
                 O_CV_P = O_G_S + (size_t)DEPTH * 128 * 4 * 16384, O_CV_S = O_CV_P + (size_t)DEPTH * 8 * 3 * 1536, O_END = O_CV_S + (size_t)DEPTH * 128 * 3 * 1536;

struct P { const float* in[26]; float* out; unsigned char* ws; int lo, hi; };
enum { I_XP = 0, I_XS, I_SA, I_SC, I_SN, I_SM, I_SG, I_SV, I_WIN, I_LB, I_ANG, I_BMI, I_BMF, I_BNG, I_CW, I_ALOG, I_DTB, I_CNG, I_WBR, I_WOUT, I_L1G, I_L1B, I_WF1, I_WF2, I_L2G, I_L2B };

__device__ __forceinline__ int my_tid() { int t = threadIdx.x; asm volatile("" : "+v"(t)); return t; }
__device__ __forceinline__ int my_bid() { int b = blockIdx.x; asm volatile("" : "+s"(b)); return b; }
__device__ __forceinline__ int my_grid() { int g = gridDim.x; asm volatile("" : "+s"(g)); return g; }
__device__ __forceinline__ float sigm(float x) { return __builtin_amdgcn_rcpf(1.0f + __expf(-x)); }
__device__ __forceinline__ float silu(float x) { return x * sigm(x); }
template <int CTRL> __device__ __forceinline__ float dppf(float x) { return __builtin_bit_cast(float, __builtin_amdgcn_mov_dpp(__builtin_bit_cast(int, x), CTRL, 0xf, 0xf, true)); }
__device__ __forceinline__ float red16(float x) { x += dppf<0xB1>(x); x += dppf<0x4E>(x); x += dppf<0x124>(x); x += dppf<0x128>(x); return x; }
__device__ __forceinline__ float red64(float x) { x = red16(x); x += __shfl_xor(x, 16); x += __shfl_xor(x, 32); return x; }

namespace pg8 {
constexpr int BM = 256, BK = 64, HALF = 128, HTB = HALF * BK * 2, STAGE_BYTES = 8 * HTB, NXCD = 8, WGM = 8;
__device__ __forceinline__ int lds_byte(int r, int c) { const int st = (r >> 4) * 2 + (c >> 5), rr = r & 15, cc = c & 31, ob = rr * 64 + cc * 2; return st * 1024 + (ob ^ (((ob >> 9) & 1) << 5)); }
__device__ __forceinline__ void stage_rc(int b, int& R, int& C) { const int st = b / 1024, sb = b % 1024, swz = sb ^ (((sb >> 9) & 1) << 5); R = (st >> 1) * 16 + swz / 64; C = (st & 1) * 32 + (swz % 64) / 2; }
__device__ __forceinline__ int perm32(int rho) { const int n = rho >> 4, i = rho & 15; return 8 * (i >> 2) + 4 * n + (i & 3); }
struct Unit { int pm, pn; };
struct Gemm { const h16* A; const h16* Bt; int M, N, K; };
struct StaticOrder {
    int nM, nN, nwg, G, c;
    __device__ void init(int M, int N, int G_, int c_) { nM = M / BM; nN = N / BM; nwg = nM * nN; G = G_; c = c_; }
    __device__ bool next(int i, Unit& u) const {
        const long L = (long)i * G + c; if (L >= nwg) return false;
        int wgid = (int)L; { const int q = nwg / NXCD, r = nwg % NXCD, xcd = wgid % NXCD, off = wgid / NXCD; wgid = (xcd < r ? xcd * (q + 1) : r * (q + 1) + (xcd - r) * q) + off; }
        const int nig = WGM * nN, gid = wgid / nig, fm = gid * WGM, gsz = (nM - fm) < WGM ? (nM - fm) : WGM;
        u.pm = fm + ((wgid % nig) % gsz); u.pn = (wgid % nig) / gsz; return true;
    }
};
struct BranchOrder {
    int G, c;
    __device__ bool next(int i, Unit& u) const {
        const int ti = i / 3, br = i - 3 * ti; const int tile = ti * G + c; if (tile >= 68 * 4) return false;
        u.pm = (tile >> 2) + 68 * br; u.pn = (tile & 3) + 4 * br; return true;
    }
};

template <class Epi, class Sched>
__device__ __forceinline__ void gemm_phase(LAS unsigned char* lds, const Gemm g, const Sched& S, const Epi& E) {
    const int tid = my_tid(), wid = __builtin_amdgcn_readfirstlane(tid >> 6), lane = tid & 63, wr = wid >> 2, wc = wid & 3, fr = lane & 15, fq = lane >> 4;
    const int K = g.K, nt = K / BK;
    unsigned voffA[2], voffB[2];
#pragma unroll
    for (int i = 0; i < 2; ++i) { int R, C; stage_rc(tid * 16 + i * 8192, R, C); const int Rb = Epi::PERM ? ((R & ~31) + perm32(R & 31)) : R;
        voffA[i] = (unsigned)(R * K + C) * 2u; voffB[i] = (unsigned)(Rb * K + C) * 2u; }
    const size_t kstep = (size_t)(BK * 2);
    const size_t hstep = (size_t)HALF * K * 2;
    const size_t tstep = 2 * hstep;
    const unsigned ldsw = (unsigned)wid * 1024u;
    const int aoff = lds_byte(wr * 64 + fr, fq * 8), boff = lds_byte(wc * 32 + fr, fq * 8);
#define PG8_SA(b, h) (((b) * 2 + (h)) * HTB)
#define PG8_SB(b, h) ((4 + (b) * 2 + (h)) * HTB)
#define PG8_STAGE(bufoff, gbase, voff) do { _Pragma("unroll") for (int _i = 0; _i < 2; ++_i) \
        __builtin_amdgcn_global_load_lds((const unsigned*)((const char*)(gbase) + (voff)[_i]), (LAS unsigned*)(lds + (bufoff) + ldsw + _i * 8192), 16, 0, 0); } while (0)
#define PG8_LDA(dst, b, h) do { _Pragma("unroll") for (int m = 0; m < 4; ++m) _Pragma("unroll") for (int k = 0; k < 2; ++k) dst[m][k] = *(const LAS h16x8*)(lds + PG8_SA(b, h) + aoff + m * 2048 + k * 1024); } while (0)
#define PG8_LDB(dst, b, h) do { _Pragma("unroll") for (int n = 0; n < 2; ++n) _Pragma("unroll") for (int k = 0; k < 2; ++k) dst[n][k] = *(const LAS h16x8*)(lds + PG8_SB(b, h) + boff + n * 2048 + k * 1024); } while (0)
#define PG8_MMA(ai, bj, At, Bt) do { __builtin_amdgcn_s_setprio(1); _Pragma("unroll") for (int m = 0; m < 4; ++m) _Pragma("unroll") for (int n = 0; n < 2; ++n) _Pragma("unroll") for (int k = 0; k < 2; ++k) \
        acc[ai][bj][m][n] = __builtin_amdgcn_mfma_f32_16x16x32_f16(Bt[n][k], At[m][k], acc[ai][bj][m][n], 0, 0, 0); __builtin_amdgcn_s_setprio(0); } while (0)
#define PG8_WAIT_V(n) asm volatile("s_waitcnt vmcnt(" #n ")" ::: "memory")
#define PG8_WAIT_L(n) asm volatile("s_waitcnt lgkmcnt(" #n ")" ::: "memory")
#define PG8_BAR __builtin_amdgcn_s_barrier()
#define PG8_SCHED __builtin_amdgcn_sched_barrier(0)
    Unit cur, nxt; int ui = 0;
    if (!S.next(0, cur)) return;
    f32x4 acc[2][2][4][2];
#pragma unroll
    for (int a = 0; a < 2; ++a)
#pragma unroll
        for (int b = 0; b < 2; ++b)
#pragma unroll
            for (int m = 0; m < 4; ++m)
#pragma unroll
                for (int n = 0; n < 2; ++n) acc[a][b][m][n] = (f32x4){0.f, 0.f, 0.f, 0.f};
    h16x8 At[4][2], B0[2][2], B1[2][2];
    const char* cA = (const char*)g.A + (size_t)cur.pm * tstep; const char* cB = (const char*)g.Bt + (size_t)cur.pn * tstep;
    PG8_STAGE(PG8_SB(0, 0), cB, voffB); PG8_STAGE(PG8_SA(0, 0), cA, voffA); PG8_STAGE(PG8_SB(0, 1), cB + hstep, voffB); PG8_STAGE(PG8_SA(0, 1), cA + hstep, voffA);
    if (wr == 1) PG8_BAR;
    PG8_WAIT_V(4); PG8_BAR;
    PG8_STAGE(PG8_SB(1, 0), cB + kstep, voffB); PG8_STAGE(PG8_SA(1, 0), cA + kstep, voffA); PG8_STAGE(PG8_SB(1, 1), cB + hstep + kstep, voffB);
    PG8_WAIT_V(6); PG8_BAR;
    for (;;) {
        const bool has_next = S.next(ui + 1, nxt);
        const char* nA = has_next ? (const char*)g.A + (size_t)nxt.pm * tstep : cA; const char* nB = has_next ? (const char*)g.Bt + (size_t)nxt.pn * tstep : cB;
        for (int t = 0; t < nt; t += 2) {
            const bool last = (t == nt - 2);
            const char* a1 = cA + (size_t)(t + 1) * kstep;
            const char* a2 = last ? nA : cA + (size_t)(t + 2) * kstep; const char* b2 = last ? nB : cB + (size_t)(t + 2) * kstep;
            const char* a3 = a2 + kstep; const char* b3 = b2 + kstep;
            PG8_LDB(B0, 0, 0); PG8_SCHED; PG8_LDA(At, 0, 0); PG8_STAGE(PG8_SA(1, 1), a1 + hstep, voffA);
            PG8_WAIT_L(8); PG8_BAR; PG8_WAIT_L(0); PG8_MMA(0, 0, At, B0); PG8_BAR; PG8_SCHED;
            PG8_LDB(B1, 0, 1); PG8_STAGE(PG8_SB(0, 0), b2, voffB);
            PG8_BAR; PG8_WAIT_L(0); PG8_MMA(0, 1, At, B1); PG8_BAR;
            PG8_LDA(At, 0, 1); PG8_STAGE(PG8_SA(0, 0), a2, voffA);
            PG8_BAR; PG8_WAIT_L(0); PG8_MMA(1, 0, At, B0); PG8_BAR; PG8_SCHED;
            PG8_STAGE(PG8_SB(0, 1), b2 + hstep, voffB);
            PG8_WAIT_V(6); PG8_BAR; PG8_MMA(1, 1, At, B1); PG8_BAR;
            PG8_LDB(B0, 1, 0); PG8_SCHED; PG8_LDA(At, 1, 0); PG8_STAGE(PG8_SA(0, 1), a2 + hstep, voffA);
            PG8_WAIT_L(8); PG8_BAR; PG8_WAIT_L(0); PG8_MMA(0, 0, At, B0); PG8_BAR; PG8_SCHED;
            PG8_LDB(B1, 1, 1); PG8_STAGE(PG8_SB(1, 0), b3, voffB);
            PG8_BAR; PG8_WAIT_L(0); PG8_MMA(0, 1, At, B1); PG8_BAR;
            PG8_LDA(At, 1, 1); PG8_STAGE(PG8_SA(1, 0), a3, voffA);
            PG8_BAR; PG8_WAIT_L(0); PG8_MMA(1, 0, At, B0); PG8_BAR; PG8_SCHED;
            PG8_STAGE(PG8_SB(1, 1), b3 + hstep, voffB);
            PG8_WAIT_V(6); PG8_BAR; PG8_MMA(1, 1, At, B1); PG8_BAR;
        }
        E(acc, cur, wr, wc, fr, fq);
        if (!has_next) break;
#pragma unroll
        for (int a = 0; a < 2; ++a)
#pragma unroll
            for (int b = 0; b < 2; ++b)
#pragma unroll
                for (int m = 0; m < 4; ++m)
#pragma unroll
                    for (int n = 0; n < 2; ++n) acc[a][b][m][n] = (f32x4){0.f, 0.f, 0.f, 0.f};
        cur = nxt; cA = nA; cB = nB; ++ui;
    }
    PG8_WAIT_V(0);
    if (wr == 0) PG8_BAR;
    PG8_BAR;
#undef PG8_SA
#undef PG8_SB
#undef PG8_STAGE
#undef PG8_LDA
#undef PG8_LDB
#undef PG8_MMA
#undef PG8_WAIT_V
#undef PG8_WAIT_L
#undef PG8_BAR
#undef PG8_SCHED
}
}
using pg8::Unit;

__device__ __forceinline__ h16x8 pack8(const f32x4 a, const f32x4 b) {
    h16x8 o; o[0] = (h16)a[0]; o[1] = (h16)a[1]; o[2] = (h16)a[2]; o[3] = (h16)a[3]; o[4] = (h16)b[0]; o[5] = (h16)b[1]; o[6] = (h16)b[2]; o[7] = (h16)b[3]; return o;
}

struct EpiIn {
    static constexpr bool PERM = true;
    h16* proj; float* gates; const float* lb; const float* b_mi; const float* b_mf; const float* a_log; const float* dt_bias;
    __device__ __forceinline__ void operator()(const f32x4 (&acc)[2][2][4][2], const Unit& u, int wr, int wc, int fr, int fq) const {
        const int pn = u.pn; const int row0 = u.pm * 256 + wr * 64 + fr;
        if (pn == 34) {
            if (wc == 0 && fq < 2) {
                f32x4 c0, c1;
                if (fq == 0) { c0 = *(const f32x4*)b_mi; c1 = *(const f32x4*)b_mf; } else { c0 = *(const f32x4*)a_log; c1 = *(const f32x4*)dt_bias; }
#pragma unroll
                for (int ai = 0; ai < 2; ++ai)
#pragma unroll
                    for (int m = 0; m < 4; ++m) {
                        const f32x4 x0 = acc[ai][0][m][0], x1 = acc[ai][0][m][1]; f32x4 y0, y1;
#pragma unroll
                        for (int j = 0; j < 4; ++j) {
                            if (fq == 0) { y0[j] = x0[j] + c0[j]; const float z = x1[j] + c1[j]; y1[j] = fminf(z, 0.f) - log1pf(__expf(-fabsf(z))); }
                            else { y0[j] = sigm(x0[j]); const float z = x1[j] + c1[j]; y1[j] = -__expf(c0[j]) * (fmaxf(z, 0.f) + log1pf(__expf(-fabsf(z)))); }
                        }
                        float* gp = gates + (size_t)(row0 + ai * 128 + m * 16) * 16 + 8 * fq;
                        *(f32x4*)gp = y0; *(f32x4*)(gp + 4) = y1;
                    }
            }
            return;
        }
        int mode = 0;
        if (pn < 2) mode = 1; else if (pn < 4) mode = 3; else if (pn < 6) mode = 0; else if (pn < 8) mode = 1; else if (pn == 8) mode = 4; else if (pn < 12) mode = 0;
        else if (pn < 14) mode = 2; else if (pn < 20) mode = 0; else if (pn < 22) mode = 1; else mode = 2;
        const int col0 = pn * 256 + wc * 32 + 8 * fq;
        f32x4 lbv[2][2];
        if (mode == 3) {
#pragma unroll
            for (int bj = 0; bj < 2; ++bj)
#pragma unroll
                for (int n = 0; n < 2; ++n) lbv[bj][n] = 1.0f - *(const f32x4*)(lb + (col0 - C_AF) + bj * 128 + 4 * n);
        }
#pragma unroll
        for (int ai = 0; ai < 2; ++ai)
#pragma unroll
            for (int m = 0; m < 4; ++m) {
                h16* rowp = proj + (size_t)(row0 + ai * 128 + m * 16) * NPROJ + col0;
#pragma unroll
                for (int bj = 0; bj < 2; ++bj) {
                    f32x4 v[2] = {acc[ai][bj][m][0], acc[ai][bj][m][1]};
                    if (mode == 1) { for (int n = 0; n < 2; ++n) for (int j = 0; j < 4; ++j) v[n][j] = silu(v[n][j]); }
                    else if (mode == 2) { for (int n = 0; n < 2; ++n) for (int j = 0; j < 4; ++j) v[n][j] = sigm(v[n][j]); }
                    else if (mode == 3) { for (int n = 0; n < 2; ++n) for (int j = 0; j < 4; ++j) v[n][j] = lbv[bj][n][j] * sigm(-v[n][j]); }
                    else if (mode == 4) { v[0] *= 0.125f; v[1] *= 0.125f; }
                    *(h16x8*)(rowp + bj * 128) = pack8(v[0], v[1]);
                }
            }
    }
};
struct EpiBranch {
    static constexpr bool PERM = true;
    const h16* proj; float* mrg32; h16* mrg16;
    __device__ __forceinline__ void operator()(const f32x4 (&acc)[2][2][4][2], const Unit& u, int wr, int wc, int fr, int fq) const {
        const int br = u.pn >> 2; const int pn = u.pn & 3, pm = u.pm - 68 * br;
        const int row0 = pm * 256 + wr * 64 + fr, col0 = pn * 256 + wc * 32 + 8 * fq;
#pragma unroll
        for (int ai = 0; ai < 2; ++ai)
#pragma unroll
            for (int m = 0; m < 4; ++m) {
                const size_t row = (size_t)(row0 + ai * 128 + m * 16);
#pragma unroll
                for (int bj = 0; bj < 2; ++bj) {
                    const h16x8 gt = *(const h16x8*)(proj + row * NPROJ + C_MG + br * 1024 + col0 + bj * 128);
                    float* mp = mrg32 + row * DM + col0 + bj * 128;
                    f32x4 v0 = acc[ai][bj][m][0], v1 = acc[ai][bj][m][1];
#pragma unroll
                    for (int j = 0; j < 4; ++j) { v0[j] *= (float)gt[j]; v1[j] *= (float)gt[4 + j]; }
                    if (br > 0) { v0 += *(const f32x4*)mp; v1 += *(const f32x4*)(mp + 4); }
                    if (br < 2) { *(f32x4*)mp = v0; *(f32x4*)(mp + 4) = v1; }
                    else *(h16x8*)(mrg16 + row * DM + col0 + bj * 128) = pack8(v0, v1);
                }
            }
    }
};
struct EpiRes {
    static constexpr bool PERM = false;
    const float* h32; float* pre32;
    __device__ __forceinline__ void operator()(const f32x4 (&acc)[2][2][4][2], const Unit& u, int wr, int wc, int fr, int fq) const {
        const int row0 = u.pm * 256 + wr * 64 + fr, col0 = u.pn * 256 + wc * 32 + 4 * fq;
#pragma unroll
        for (int ai = 0; ai < 2; ++ai)
#pragma unroll
            for (int m = 0; m < 4; ++m) {
                const size_t off = (size_t)(row0 + ai * 128 + m * 16) * DM + col0;
#pragma unroll
                for (int bj = 0; bj < 2; ++bj)
#pragma unroll
                    for (int n = 0; n < 2; ++n) { const f32x4 hv = *(const f32x4*)(h32 + off + bj * 128 + n * 16); *(f32x4*)(pre32 + off + bj * 128 + n * 16) = ALPHA * hv + acc[ai][bj][m][n]; }
            }
    }
};
struct EpiSwiglu {
    static constexpr bool PERM = true;
    h16* ff;
    __device__ __forceinline__ void operator()(const f32x4 (&acc)[2][2][4][2], const Unit& u, int wr, int wc, int fr, int fq) const {
        const int row0 = u.pm * 256 + wr * 64 + fr, col0 = u.pn * 128 + wc * 32 + 8 * fq;
#pragma unroll
        for (int ai = 0; ai < 2; ++ai)
#pragma unroll
            for (int m = 0; m < 4; ++m) {
                f32x4 v[2];
#pragma unroll
                for (int n = 0; n < 2; ++n)
#pragma unroll
                    for (int j = 0; j < 4; ++j) v[n][j] = silu(acc[ai][0][m][n][j]) * acc[ai][1][m][n][j];
                *(h16x8*)(ff + (size_t)(row0 + ai * 128 + m * 16) * FFH + col0) = pack8(v[0], v[1]);
            }
    }
};

__device__ __forceinline__ int map_in(int n) {
    if (n < 3584) return n;
    if (n < 5632) return n + 8;
    if (n < 8704) return n + 16;
    if (n < 8708) return 3584 + (n - 8704);
    if (n < 8712) return 3588 + (n - 8708);
    if (n < 8716) return 5640 + (n - 8712);
    if (n < 8720) return 5644 + (n - 8716);
    return -1;
}
__device__ __forceinline__ int map_f1(int n) { const int p = n >> 8, w = n & 255; return w < 128 ? 128 * p + w : FFH + 128 * p + (w - 128); }
__device__ __forceinline__ void tr_tile(const float* __restrict__ src, int Nsrc, h16* __restrict__ dst, int K, int n0, int k0, int mapid, LAS float* tile) {
    const int tid = my_tid(), tx = tid & 63, ty = tid >> 6;
    const int n = n0 + tx; const int sc = mapid == 0 ? n : (mapid == 1 ? map_in(n) : map_f1(n));
#pragma unroll
    for (int p = 0; p < 8; ++p) { const int k = ty + 8 * p; tile[k * 65 + tx] = sc >= 0 ? src[(size_t)(k0 + k) * Nsrc + sc] : 0.f; }
    __syncthreads();
    const int kx = (tid & 31) * 2, ny = tid >> 5;
#pragma unroll
    for (int p = 0; p < 4; ++p) { const int nn = ny + 16 * p; h16x2 o; o[0] = (h16)tile[kx * 65 + nn]; o[1] = (h16)tile[(kx + 1) * 65 + nn]; *(h16x2*)(dst + (size_t)(n0 + nn) * K + k0 + kx) = o; }
    __syncthreads();
}
__device__ void phase_prep(const P& p, LAS unsigned char* lds) {
    LAS float* tile = (LAS float*)lds;
    unsigned char* ws = p.ws;
    constexpr int T_IN = (NPROJ / 64) * (DM / 64), T_BR = 3 * (1024 / 64) * (512 / 64), T_OUT = 16 * 16, T_F1 = (2 * FFH / 64) * 16, T_F2 = 16 * (FFH / 64), T_L = T_IN + T_BR + T_OUT + T_F1 + T_F2;
    for (int id = my_bid(); id < DEPTH * T_L; id += my_grid()) {
        const int l = id / T_L; int r = id - l * T_L;
        if (r < T_IN) { const int tn = r / 16, tk = r % 16; tr_tile(p.in[I_WIN] + (size_t)l * DM * NSRC_IN, NSRC_IN, (h16*)(ws + WS_WIN) + (size_t)l * NPROJ * DM, DM, tn * 64, tk * 64, 1, tile); continue; }
        r -= T_IN;
        if (r < T_BR) { const int br = r / 128, q = r % 128, tn = q / 8, tk = q % 8; tr_tile(p.in[I_WBR] + ((size_t)l * 3 + br) * 512 * 1024, 1024, (h16*)(ws + WS_WBR) + ((size_t)l * 3 + br) * 1024 * 512, 512, tn * 64, tk * 64, 0, tile); continue; }
        r -= T_BR;
        if (r < T_OUT) { const int tn = r / 16, tk = r % 16; tr_tile(p.in[I_WOUT] + (size_t)l * DM * DM, DM, (h16*)(ws + WS_WOUT) + (size_t)l * DM * DM, DM, tn * 64, tk * 64, 0, tile); continue; }
        r -= T_OUT;
        if (r < T_F1) { const int tn = r / 16, tk = r % 16; tr_tile(p.in[I_WF1] + (size_t)l * DM * 2 * FFH, 2 * FFH, (h16*)(ws + WS_WF1) + (size_t)l * 2 * FFH * DM, DM, tn * 64, tk * 64, 2, tile); continue; }
        r -= T_F1;
        { const int tn = r / (FFH / 64), tk = r % (FFH / 64); tr_tile(p.in[I_WF2] + (size_t)l * FFH * DM, DM, (h16*)(ws + WS_WF2) + (size_t)l * DM * FFH, FFH, tn * 64, tk * 64, 0, tile); }
    }
    if (my_bid() == 0) {
        const int c = my_tid(); const float* lg = p.in[I_LB];
        const float a0 = lg[c], a1 = lg[512 + c], a2 = lg[1024 + c], a3 = lg[1536 + c]; const float mx = fmaxf(fmaxf(a0, a1), fmaxf(a2, a3));
        const float e0 = expf(a0 - mx), e1 = expf(a1 - mx), e2 = expf(a2 - mx), e3 = expf(a3 - mx), inv = 1.0f / (e0 + e1 + e2 + e3);
        float* lb = (float*)(ws + WS_LB); lb[c] = 0.f; lb[512 + c] = e1 * inv; lb[1024 + c] = (e1 + e2) * inv; lb[1536 + c] = (e1 + e2 + e3) * inv;
    }
    float* h32 = (float*)(ws + WS_H32); h16* hh = (h16*)(ws + WS_R1);
    const size_t n4 = (size_t)T * DM / 4, np4 = (size_t)TP * DM / 4;
    for (size_t i = (size_t)my_bid() * NTHREADS + my_tid(); i < n4; i += (size_t)my_grid() * NTHREADS) {
        const f32x4 v = i < np4 ? ((const f32x4*)p.in[I_XP])[i] : ((const f32x4*)p.in[I_XS])[i - np4];
        ((f32x4*)h32)[i] = v; h16x4 o; o[0] = (h16)v[0]; o[1] = (h16)v[1]; o[2] = (h16)v[2]; o[3] = (h16)v[3]; ((h16x4*)hh)[i] = o;
    }
}

__device__ void phase_conv(const P& p, int l) {
    const int lane = my_tid() & 63, wv = my_tid() >> 6, seg = lane & 15, hg = lane >> 4;
    const h16* proj = (const h16*)(p.ws + WS_P); h16* cprep = (h16*)(p.ws + WS_R1);
    const float* cw = p.in[I_CW] + (size_t)l * 4 * 1536;
    for (int r = my_bid() + my_grid() * wv; r < T; r += my_grid() * NWAVES) {
        int b, pos, L, grp; if (r < TP) { grp = 0; b = r >> 11; pos = r & 2047; L = 2048; } else { grp = 1; b = (r - TP) >> 3; pos = (r - TP) & 7; L = 8; }
#pragma unroll 1
        for (int it = 0; it < 3; ++it) {
            const int c = it * 512 + hg * 128 + seg * 8;
            float a[8];
#pragma unroll
            for (int j = 0; j < 8; ++j) a[j] = 0.f;
            h16x8 xc;
#pragma unroll
            for (int d = 0; d < 4; ++d) {
                float xv[8]; bool have = true;
                if (pos - d >= 0) { const h16x8 x = *(const h16x8*)(proj + (size_t)(r - d) * NPROJ + C_CX + c); if (d == 0) xc = x;
#pragma unroll
                    for (int j = 0; j < 8; ++j) xv[j] = (float)x[j]; }
                else if (grp) { const float* sp = p.in[I_SV] + (((size_t)l * 128 + b) * 3 + (3 + pos - d)) * 1536 + c; const f32x4 s0 = *(const f32x4*)sp, s1 = *(const f32x4*)(sp + 4);
#pragma unroll
                    for (int j = 0; j < 4; ++j) { xv[j] = s0[j]; xv[4 + j] = s1[j]; } }
                else have = false;
                if (have) { const f32x4 w0 = *(const f32x4*)(cw + (3 - d) * 1536 + c), w1 = *(const f32x4*)(cw + (3 - d) * 1536 + c + 4);
#pragma unroll
                    for (int j = 0; j < 4; ++j) { a[j] += xv[j] * w0[j]; a[4 + j] += xv[4 + j] * w1[j]; } }
            }
            float ss = 0.f;
#pragma unroll
            for (int j = 0; j < 8; ++j) { a[j] = silu(a[j]); ss += a[j] * a[j]; }
            if (it < 2) { ss = red16(ss); const float sc = rsqrtf(ss + 1e-6f) * (it == 0 ? 0.08838834764831845f : 1.0f);
#pragma unroll
                for (int j = 0; j < 8; ++j) a[j] *= sc; }
            h16x8 o;
#pragma unroll
            for (int j = 0; j < 8; ++j) o[j] = (h16)a[j];
            *(h16x8*)(cprep + (size_t)r * 1536 + c) = o;
            if (pos >= L - 3) {
                float* op = p.out + (grp ? O_CV_S + (((size_t)l * 128 + b) * 3 + (pos - (L - 3))) * 1536 : O_CV_P + (((size_t)l * 8 + b) * 3 + (pos - (L - 3))) * 1536) + c;
                f32x4 o0, o1;
#pragma unroll
                for (int j = 0; j < 4; ++j) { o0[j] = (float)xc[j]; o1[j] = (float)xc[4 + j]; }
                *(f32x4*)op = o0; *(f32x4*)(op + 4) = o1;
            }
        }
    }
}

template <int NC> __device__ __forceinline__ void ld_h(const h16* p, float (&v)[NC]) {
    if constexpr (NC == 2) { const h16x2 x = *(const h16x2*)p; v[0] = (float)x[0]; v[1] = (float)x[1]; }
    else { const h16x8 x = *(const h16x8*)p;
#pragma unroll
        for (int j = 0; j < 8; ++j) v[j] = (float)x[j]; }
}
template <int NC> __device__ __forceinline__ void st_f(float* p, const float (&v)[NC]) {
    if constexpr (NC == 2) { *(f32x2*)p = (f32x2){v[0], v[1]}; }
    else { *(f32x4*)p = (f32x4){v[0], v[1], v[2], v[3]}; *(f32x4*)(p + 4) = (f32x4){v[4], v[5], v[6], v[7]}; }
}
template <int NC> __device__ __forceinline__ void ld_f(const float* p, float (&v)[NC]) {
    if constexpr (NC == 2) { const f32x2 x = *(const f32x2*)p; v[0] = x[0]; v[1] = x[1]; }
    else { const f32x4 x = *(const f32x4*)p, y = *(const f32x4*)(p + 4);
#pragma unroll
        for (int j = 0; j < 4; ++j) { v[j] = x[j]; v[4 + j] = y[j]; } }
}

template <int NC> __device__ void scanA(const P& p, int l, int grp, int b, int h, int unit, int lane) {
    const int seg = lane & 15, cgp = lane >> 4; const int L = grp ? 8 : 2048; const size_t row0 = grp ? (size_t)TP + b * 8 : (size_t)b * 2048;
    const int c0 = unit * (4 * NC) + cgp * NC;
    float S[8][NC];
    const size_t sidx = (size_t)h * 16384 + (size_t)(8 * seg) * 128 + c0;
    if (grp) { const float* sp = p.in[I_SA] + ((size_t)l * 128 + b) * 65536 + sidx;
#pragma unroll
        for (int r = 0; r < 8; ++r) ld_f<NC>(sp + r * 128, S[r]); }
    else {
#pragma unroll
        for (int r = 0; r < 8; ++r)
#pragma unroll
            for (int j = 0; j < NC; ++j) S[r][j] = 0.f; }
    const h16* base = (const h16*)(p.ws + WS_P) + row0 * NPROJ + h * 128;
    float* ob = (float*)(p.ws + WS_R2) + row0 * 1536 + h * 128 + c0;
    h16x8 qn = *(const h16x8*)(base + C_AQ + 8 * seg), kn = *(const h16x8*)(base + C_AF + 8 * seg); float vn[NC]; ld_h<NC>(base + C_AI + c0, vn);
#pragma unroll 1
    for (int t = 0; t < L; ++t) {
        const h16x8 q8 = qn, k8 = kn; float v[NC];
#pragma unroll
        for (int j = 0; j < NC; ++j) v[j] = vn[j];
        if (t + 1 < L) { const h16* nb = base + (size_t)(t + 1) * NPROJ; qn = *(const h16x8*)(nb + C_AQ + 8 * seg); kn = *(const h16x8*)(nb + C_AF + 8 * seg); ld_h<NC>(nb + C_AI + c0, vn); }
        float o[NC];
#pragma unroll
        for (int j = 0; j < NC; ++j) o[j] = 0.f;
#pragma unroll
        for (int r = 0; r < 8; ++r) { const float kk = (float)k8[r], qq = (float)q8[r];
#pragma unroll
            for (int j = 0; j < NC; ++j) { S[r][j] += kk * (v[j] - S[r][j]); o[j] += S[r][j] * qq; } }
#pragma unroll
        for (int j = 0; j < NC; ++j) o[j] = red16(o[j]);
        if (seg == 0) st_f<NC>(ob + (size_t)t * 1536, o);
    }
    float* op = p.out + (grp ? O_HA_S + ((size_t)l * 128 + b) * 65536 : O_HA_P + ((size_t)l * 8 + b) * 65536) + sidx;
#pragma unroll
    for (int r = 0; r < 8; ++r) st_f<NC>(op + r * 128, S[r]);
}
template <int NC> __device__ void scanC(const P& p, int l, int grp, int b, int h, int unit, int lane) {
    const int seg = lane & 15, cgp = lane >> 4; const int L = grp ? 8 : 2048; const size_t row0 = grp ? (size_t)TP + b * 8 : (size_t)b * 2048;
    const int c0 = unit * (4 * NC) + cgp * NC;
    float S[8][NC];
    const size_t sidx = (size_t)h * 16384 + (size_t)(8 * seg) * 128 + c0;
    if (grp) { const float* sp = p.in[I_SG] + ((size_t)l * 128 + b) * 65536 + sidx;
#pragma unroll
        for (int r = 0; r < 8; ++r) ld_f<NC>(sp + r * 128, S[r]); }
    else {
#pragma unroll
        for (int r = 0; r < 8; ++r)
#pragma unroll
            for (int j = 0; j < NC; ++j) S[r][j] = 0.f; }
    const h16* base = (const h16*)(p.ws + WS_R1) + row0 * 1536 + h * 128;
    const float* gt = (const float*)(p.ws + WS_G) + row0 * 16 + h;
    float* ob = (float*)(p.ws + WS_R2) + row0 * 1536 + 1024 + h * 128 + c0;
    h16x8 qn = *(const h16x8*)(base + 8 * seg), kn = *(const h16x8*)(base + 512 + 8 * seg); float vn[NC]; ld_h<NC>(base + 1024 + c0, vn);
    float betan = gt[8], gn = gt[12];
#pragma unroll 1
    for (int t = 0; t < L; ++t) {
        const h16x8 q8 = qn, k8 = kn; float v[NC]; const float beta = betan, a = __expf(gn);
#pragma unroll
        for (int j = 0; j < NC; ++j) v[j] = vn[j];
        if (t + 1 < L) { const h16* nb = base + (size_t)(t + 1) * 1536; qn = *(const h16x8*)(nb + 8 * seg); kn = *(const h16x8*)(nb + 512 + 8 * seg); ld_h<NC>(nb + 1024 + c0, vn);
            betan = gt[(size_t)(t + 1) * 16 + 8]; gn = gt[(size_t)(t + 1) * 16 + 12]; }
        float kf[8], qf[8];
#pragma unroll
        for (int r = 0; r < 8; ++r) { kf[r] = (float)k8[r]; qf[r] = (float)q8[r]; }
        float u[NC];
#pragma unroll
        for (int j = 0; j < NC; ++j) u[j] = 0.f;
#pragma unroll
        for (int r = 0; r < 8; ++r)
#pragma unroll
            for (int j = 0; j < NC; ++j) u[j] += S[r][j] * kf[r];
        float o[NC];
#pragma unroll
        for (int j = 0; j < NC; ++j) { u[j] = red16(u[j]); u[j] = beta * (v[j] - a * u[j]); o[j] = 0.f; }
#pragma unroll
        for (int r = 0; r < 8; ++r)
#pragma unroll
            for (int j = 0; j < NC; ++j) { S[r][j] = a * S[r][j] + kf[r] * u[j]; o[j] += S[r][j] * qf[r]; }
#pragma unroll
        for (int j = 0; j < NC; ++j) o[j] = red16(o[j]);
        if (seg == 0) st_f<NC>(ob + (size_t)t * 1536, o);
    }
    float* op = p.out + (grp ? O_G_S + ((size_t)l * 128 + b) * 65536 : O_G_P + ((size_t)l * 8 + b) * 65536) + sidx;
#pragma unroll
    for (int r = 0; r < 8; ++r) st_f<NC>(op + r * 128, S[r]);
}
template <int NV> __device__ void scanB(const P& p, int l, int grp, int b, int h, int unit, int lane) {
    const int seg = lane & 15, vg = lane >> 4; const int L = grp ? 8 : 2048; const size_t row0 = grp ? (size_t)TP + b * 8 : (size_t)b * 2048;
    const int v0 = unit * (4 * NV) + vg * NV;
    float C[NV][4], nn[4], m;
    const size_t cidx = (size_t)h * 8192 + (size_t)v0 * 64 + 4 * seg;
    if (grp) { const float* sp = p.in[I_SC] + ((size_t)l * 128 + b) * 32768 + cidx;
#pragma unroll
        for (int i = 0; i < NV; ++i) { const f32x4 x = *(const f32x4*)(sp + i * 64); C[i][0] = x[0]; C[i][1] = x[1]; C[i][2] = x[2]; C[i][3] = x[3]; }
        const f32x4 x = *(const f32x4*)(p.in[I_SN] + (((size_t)l * 128 + b) * 4 + h) * 64 + 4 * seg); nn[0] = x[0]; nn[1] = x[1]; nn[2] = x[2]; nn[3] = x[3];
        m = p.in[I_SM][((size_t)l * 128 + b) * 4 + h]; }
    else {
#pragma unroll
        for (int i = 0; i < NV; ++i) { C[i][0] = 0.f; C[i][1] = 0.f; C[i][2] = 0.f; C[i][3] = 0.f; }
        nn[0] = nn[1] = nn[2] = nn[3] = 0.f; m = 0.f; }
    const h16* base = (const h16*)(p.ws + WS_P) + row0 * NPROJ;
    const float* gt = (const float*)(p.ws + WS_G) + row0 * 16 + h;
    float* ob = (float*)(p.ws + WS_R2) + row0 * 1536 + 512 + h * 128 + v0;
    h16x4 qn = *(const h16x4*)(base + C_BQ + h * 64 + 4 * seg), kn = *(const h16x4*)(base + C_BK + h * 64 + 4 * seg); float vn[NV]; ld_h<NV>(base + C_BV + h * 128 + v0, vn);
    float ign = gt[0], lfn = gt[4];
#pragma unroll 1
    for (int t = 0; t < L; ++t) {
        const h16x4 q4 = qn, k4 = kn; float v[NV]; const float ig = ign, lf = lfn;
#pragma unroll
        for (int i = 0; i < NV; ++i) v[i] = vn[i];
        if (t + 1 < L) { const h16* nb = base + (size_t)(t + 1) * NPROJ; qn = *(const h16x4*)(nb + C_BQ + h * 64 + 4 * seg); kn = *(const h16x4*)(nb + C_BK + h * 64 + 4 * seg); ld_h<NV>(nb + C_BV + h * 128 + v0, vn);
            ign = gt[(size_t)(t + 1) * 16]; lfn = gt[(size_t)(t + 1) * 16 + 4]; }
        const float mn = fmaxf(lf + m, ig), wo = __expf(lf + m - mn), wi = __expf(ig - mn); m = mn;
        float kf[4], qf[4];
#pragma unroll
        for (int r = 0; r < 4; ++r) { kf[r] = (float)k4[r]; qf[r] = (float)q4[r]; }
        float den = 0.f;
#pragma unroll
        for (int r = 0; r < 4; ++r) { nn[r] = wo * nn[r] + wi * kf[r]; den += nn[r] * qf[r]; }
        float num[NV];
#pragma unroll
        for (int i = 0; i < NV; ++i) { const float wv = wi * v[i]; num[i] = 0.f;
#pragma unroll
            for (int r = 0; r < 4; ++r) { C[i][r] = wo * C[i][r] + wv * kf[r]; num[i] += C[i][r] * qf[r]; } }
        den = red16(den);
        const float inv = 1.0f / fmaxf(fabsf(den), __expf(-m));
#pragma unroll
        for (int i = 0; i < NV; ++i) num[i] = red16(num[i]) * inv;
        if (seg == 0) st_f<NV>(ob + (size_t)t * 1536, num);
    }
    float* op = p.out + (grp ? O_MC_S + ((size_t)l * 128 + b) * 32768 : O_MC_P + ((size_t)l * 8 + b) * 32768) + cidx;
#pragma unroll
    for (int i = 0; i < NV; ++i) *(f32x4*)(op + i * 64) = (f32x4){C[i][0], C[i][1], C[i][2], C[i][3]};
    if (unit == 0 && vg == 0) {
        const size_t bh = grp ? ((size_t)l * 128 + b) * 4 + h : ((size_t)l * 8 + b) * 4 + h;
        *(f32x4*)(p.out + (grp ? O_MN_S : O_MN_P) + bh * 64 + 4 * seg) = (f32x4){nn[0], nn[1], nn[2], nn[3]};
        if (seg == 0) p.out[(grp ? O_MM_S : O_MM_P) + bh] = m;
    }
}
__device__ void phase_scan(const P& p, int l) {
    const int lane = my_tid() & 63, wv = my_tid() >> 6; const int G = my_grid();
    if (wv < 6) {
        for (int blk = my_bid(); blk < 256; blk += G) {
            const int br = wv % 3, idx = (wv / 3) * 256 + blk, bh = idx >> 4, unit = idx & 15;
            if (br == 0) scanA<2>(p, l, 0, bh >> 2, bh & 3, unit, lane);
            else if (br == 1) scanB<2>(p, l, 0, bh >> 2, bh & 3, unit, lane);
            else scanC<2>(p, l, 0, bh >> 2, bh & 3, unit, lane);
        }
    } else {
        for (int su = my_bid() + G * (wv - 6); su < 6144; su += 2 * G) {
            const int br = su / 2048, idx = su % 2048, bh = idx >> 2, unit = idx & 3;
            if (br == 0) scanA<8>(p, l, 1, bh >> 2, bh & 3, unit, lane);
            else if (br == 1) scanB<8>(p, l, 1, bh >> 2, bh & 3, unit, lane);
            else scanC<8>(p, l, 1, bh >> 2, bh & 3, unit, lane);
        }
    }
}

__device__ void phase_norm(const P& p, int l) {
    const int lane = my_tid() & 63, wv = my_tid() >> 6, seg = lane & 15, hg = lane >> 4;
    const h16* proj = (const h16*)(p.ws + WS_P); const float* ob = (const float*)(p.ws + WS_R2); h16* ys = (h16*)(p.ws + WS_R1);
    for (int r = my_bid() + my_grid() * wv; r < T; r += my_grid() * NWAVES) {
#pragma unroll
        for (int it = 0; it < 3; ++it) {
            const int c = hg * 128 + seg * 8;
            const float* op = ob + (size_t)r * 1536 + it * 512 + c; const f32x4 o0 = *(const f32x4*)op, o1 = *(const f32x4*)(op + 4);
            float ss = 0.f;
#pragma unroll
            for (int j = 0; j < 4; ++j) ss += o0[j] * o0[j] + o1[j] * o1[j];
            ss = red16(ss); const float rs = rsqrtf(ss * (1.0f / 128.0f) + 1e-6f);
            const h16x8 gt = *(const h16x8*)(proj + (size_t)r * NPROJ + (it == 0 ? C_AG : (it == 1 ? C_BO : C_CG)) + c);
            const float* gp = p.in[it == 0 ? I_ANG : (it == 1 ? I_BNG : I_CNG)] + l * 512 + c; const f32x4 g0 = *(const f32x4*)gp, g1 = *(const f32x4*)(gp + 4);
            h16x8 y;
#pragma unroll
            for (int j = 0; j < 4; ++j) { y[j] = (h16)(o0[j] * rs * g0[j] * (float)gt[j]); y[4 + j] = (h16)(o1[j] * rs * g1[j] * (float)gt[4 + j]); }
            *(h16x8*)(ys + ((size_t)it * T + r) * 512 + c) = y;
        }
    }
}

__device__ void phase_ln(const P& p, const float* g, const float* bta, float* dst32) {
    const int lane = my_tid() & 63, wv = my_tid() >> 6;
    const float* pre = (const float*)(p.ws + WS_R2); h16* hh = (h16*)(p.ws + WS_R1);
    for (int r = my_bid() + my_grid() * wv; r < T; r += my_grid() * NWAVES) {
        f32x4 x[4]; float s = 0.f;
#pragma unroll
        for (int i = 0; i < 4; ++i) { x[i] = *(const f32x4*)(pre + (size_t)r * DM + 256 * i + 4 * lane); s += (x[i][0] + x[i][1]) + (x[i][2] + x[i][3]); }
        const float mu = red64(s) * (1.0f / DM); float q = 0.f;
#pragma unroll
        for (int i = 0; i < 4; ++i) { x[i] -= mu; q += (x[i][0] * x[i][0] + x[i][1] * x[i][1]) + (x[i][2] * x[i][2] + x[i][3] * x[i][3]); }
        const float rstd = rsqrtf(red64(q) * (1.0f / DM) + 1e-5f);
#pragma unroll
        for (int i = 0; i < 4; ++i) { const int c = 256 * i + 4 * lane; const f32x4 y = x[i] * rstd * *(const f32x4*)(g + c) + *(const f32x4*)(bta + c);
            *(f32x4*)(dst32 + (size_t)r * DM + c) = y; h16x4 o; o[0] = (h16)y[0]; o[1] = (h16)y[1]; o[2] = (h16)y[2]; o[3] = (h16)y[3]; *(h16x4*)(hh + (size_t)r * DM + c) = o; }
    }
}

#define PHASE_FN __device__ __forceinline__
PHASE_FN void ph_gemm_in(const P& p, int l, LAS unsigned char* lds) {
    unsigned char* ws = p.ws;
    pg8::Gemm g{(const h16*)(ws + WS_R1), (const h16*)(ws + WS_WIN) + (size_t)l * NPROJ * DM, T, NPROJ, DM}; pg8::StaticOrder S; S.init(T, NPROJ, my_grid(), my_bid());
    EpiIn E{(h16*)(ws + WS_P), (float*)(ws + WS_G), (const float*)(ws + WS_LB) + l * 512, p.in[I_BMI] + l * 4, p.in[I_BMF] + l * 4, p.in[I_ALOG] + l * 4, p.in[I_DTB] + l * 4};
    pg8::gemm_phase(lds, g, S, E);
}
PHASE_FN void ph_gemm_br(const P& p, int l, LAS unsigned char* lds) {
    unsigned char* ws = p.ws;
    pg8::Gemm g{(const h16*)(ws + WS_R1), (const h16*)(ws + WS_WBR) + (size_t)l * 3072 * 512, 3 * T, 3072, 512}; pg8::BranchOrder S{(int)my_grid(), (int)my_bid()};
    EpiBranch E{(const h16*)(ws + WS_P), (float*)(ws + WS_R2), (h16*)(ws + WS_R2 + (size_t)T * DM * 4)};
    pg8::gemm_phase(lds, g, S, E);
}
PHASE_FN void ph_gemm_out(const P& p, int l, LAS unsigned char* lds) {
    unsigned char* ws = p.ws;
    pg8::Gemm g{(const h16*)(ws + WS_R2 + (size_t)T * DM * 4), (const h16*)(ws + WS_WOUT) + (size_t)l * DM * DM, T, DM, DM}; pg8::StaticOrder S; S.init(T, DM, my_grid(), my_bid());
    EpiRes E{(const float*)(ws + WS_H32), (float*)(ws + WS_R2)};
    pg8::gemm_phase(lds, g, S, E);
}
PHASE_FN void ph_gemm_f1(const P& p, int l, LAS unsigned char* lds) {
    unsigned char* ws = p.ws;
    pg8::Gemm g{(const h16*)(ws + WS_R1), (const h16*)(ws + WS_WF1) + (size_t)l * 2 * FFH * DM, T, 2 * FFH, DM}; pg8::StaticOrder S; S.init(T, 2 * FFH, my_grid(), my_bid());
    EpiSwiglu E{(h16*)(ws + WS_P)};
    pg8::gemm_phase(lds, g, S, E);
}
PHASE_FN void ph_gemm_f2(const P& p, int l, LAS unsigned char* lds) {
    unsigned char* ws = p.ws;
    pg8::Gemm g{(const h16*)(ws + WS_P), (const h16*)(ws + WS_WF2) + (size_t)l * DM * FFH, T, DM, FFH}; pg8::StaticOrder S; S.init(T, DM, my_grid(), my_bid());
    EpiRes E{(const float*)(ws + WS_H32), (float*)(ws + WS_R2)};
    pg8::gemm_phase(lds, g, S, E);
}
PHASE_FN void ph_prep(const P& p, LAS unsigned char* lds) { phase_prep(p, lds); }
PHASE_FN void ph_conv(const P& p, int l) { phase_conv(p, l); }
PHASE_FN void ph_scan(const P& p, int l) { phase_scan(p, l); }
PHASE_FN void ph_norm(const P& p, int l) { phase_norm(p, l); }
PHASE_FN void ph_ln(const P& p, int l, int which) {
    float* h32 = (float*)(p.ws + WS_H32);
    if (which == 0) phase_ln(p, p.in[I_L1G] + l * DM, p.in[I_L1B] + l * DM, h32);
    else phase_ln(p, p.in[I_L2G] + l * DM, p.in[I_L2B] + l * DM, l == DEPTH - 1 ? p.out + O_Y : h32);
}

template <int MASK> __global__ void __launch_bounds__(NTHREADS, 2) fwd_kernel(P p) {
    extern __shared__ __attribute__((aligned(16))) unsigned char lds_raw[];
    LAS unsigned char* lds = (LAS unsigned char*)lds_raw;
    for (int ph = p.lo; ph < p.hi; ++ph) {
        if (ph == 0) { if constexpr ((MASK & 1) != 0) ph_prep(p, lds); }
        else {
            const int l = (ph - 1) / 10, k = (ph - 1) % 10;
            switch (k) {
            case 0: if constexpr ((MASK & 2) != 0) ph_gemm_in(p, l, lds); break;
            case 1: if constexpr ((MASK & 4) != 0) ph_conv(p, l); break;
            case 2: if constexpr ((MASK & 8) != 0) ph_scan(p, l); break;
            case 3: if constexpr ((MASK & 16) != 0) ph_norm(p, l); break;
            case 4: if constexpr ((MASK & 32) != 0) ph_gemm_br(p, l, lds); break;
            case 5: if constexpr ((MASK & 64) != 0) ph_gemm_out(p, l, lds); break;
            case 6: if constexpr ((MASK & 128) != 0) ph_ln(p, l, 0); break;
            case 7: if constexpr ((MASK & 256) != 0) ph_gemm_f1(p, l, lds); break;
            case 8: if constexpr ((MASK & 512) != 0) ph_gemm_f2(p, l, lds); break;
            default: if constexpr ((MASK & 1024) != 0) ph_ln(p, l, 1); break;
            }
        }
        if (ph + 1 < p.hi) cg::this_grid().sync();
    }
}

constexpr int N_PHASES = 1 + 10 * DEPTH;
constexpr int LDS_BYTES = pg8::STAGE_BYTES;
constexpr int MASK_ALL = 2047;

template <int MASK> static bool setup_k() { return hipFuncSetAttribute((const void*)fwd_kernel<MASK>, hipFuncAttributeMaxDynamicSharedMemorySize, LDS_BYTES) == hipSuccess; }
template <int MASK> static void launch_k(int grid, hipStream_t stream, const P& p) { hipLaunchKernelGGL(fwd_kernel<MASK>, dim3(grid), dim3(NTHREADS), LDS_BYTES, stream, p); }

extern "C" void kernel_launch(void* const* d_in, const int* in_sizes, int n_in, void* d_out, int out_size, void* d_ws, size_t ws_size, hipStream_t stream) {
    static int grid = 0;
    if (grid == 0) {
        if (n_in != 26 || (size_t)out_size != O_END || ws_size < WS_END) { fprintf(stderr, "kernel_launch: unexpected sizes n_in %d out %d ws %zu (need %zu)\n", n_in, out_size, ws_size, (size_t)WS_END); grid = -1; return; }
        int dev = 0, cus = 0, per_cu = 0;
        (void)hipGetDevice(&dev); (void)hipDeviceGetAttribute(&cus, hipDeviceAttributeMultiprocessorCount, dev);
#if N_LAUNCH_MODE == 1
        bool ok = setup_k<MASK_ALL>();
        if (ok && (hipOccupancyMaxActiveBlocksPerMultiprocessor(&per_cu, (const void*)fwd_kernel<MASK_ALL>, NTHREADS, LDS_BYTES) != hipSuccess || per_cu < 1)) { fprintf(stderr, "occupancy query: %d\n", per_cu); }
#else
        bool ok = setup_k<1>() && setup_k<2>() && setup_k<4>() && setup_k<8>() && setup_k<16>() && setup_k<32>() && setup_k<64>() && setup_k<128>() && setup_k<256>() && setup_k<512>() && setup_k<1024>();
#endif
        if (!ok) { fprintf(stderr, "hipFuncSetAttribute failed\n"); grid = -1; return; }
        (void)hipGetLastError();
        grid = cus;
    }
    if (grid < 0) return;
    P p{};
    for (int i = 0; i < 26; ++i) p.in[i] = (const float*)d_in[i];
    p.out = (float*)d_out; p.ws = (unsigned char*)d_ws;
#if N_LAUNCH_MODE == 1
    p.lo = 0; p.hi = N_PHASES;
    void* args[] = {&p};
    hipError_t e = hipLaunchCooperativeKernel((const void*)fwd_kernel<MASK_ALL>, dim3(grid), dim3(NTHREADS), args, LDS_BYTES, stream);
    if (e != hipSuccess) fprintf(stderr, "cooperative launch failed: %s (grid %d)\n", hipGetErrorString(e), grid);
#else
    for (int ph = 0; ph < N_PHASES; ++ph) {
        p.lo = ph; p.hi = ph + 1;
        const int k = ph == 0 ? 0 : 1 + (ph - 1) % 10;
        switch (k) {
        case 0: launch_k<1>(grid, stream, p); break;
        case 1: launch_k<2>(grid, stream, p); break;
        case 2: launch_k<4>(grid, stream, p); break;
        case 3: launch_k<8>(grid, stream, p); break;
        case 4: launch_k<16>(grid, stream, p); break;
        case 5: launch_k<32>(grid, stream, p); break;
        case 6: launch_k<64>(grid, stream, p); break;
        case 7: launch_k<128>(grid, stream, p); break;
        case 8: launch_k<256>(grid, stream, p); break;
        case 9: launch_k<512>(grid, stream, p); break;
        default: launch_k<1024>(grid, stream, p); break;
        }
    }
#endif
}
```

```cpp
#include <hip/hip_runtime.h>
#include <hip/hip_cooperative_groups.h>
#include <cstdio>
namespace cg = cooperative_groups;

#ifndef N_LAUNCH_MODE
#define N_LAUNCH_MODE 1
#endif

#ifndef DUP_MASK
#define DUP_MASK 0
#endif
#define LAS __attribute__((address_space(3)))
typedef _Float16 h16;
typedef _Float16 h16x8 __attribute__((ext_vector_type(8)));
typedef _Float16 h16x4 __attribute__((ext_vector_type(4)));
typedef _Float16 h16x2 __attribute__((ext_vector_type(2)));
typedef float f32x4 __attribute__((ext_vector_type(4)));
typedef float f32x2 __attribute__((ext_vector_type(2)));

constexpr int DM = 1024, TP = 16384, TS = 1024, T = TP + TS, DEPTH = 4;
constexpr int NSRC_IN = 8720, NPROJ = 8960, FFH = 2816;
constexpr int NTHREADS = 512, NWAVES = 8;
constexpr float ALPHA = 1.681792830507429f;
constexpr int C_AQ = 0, C_AF = 512, C_AI = 1024, C_AG = 1536, C_BQ = 2048, C_BK = 2304, C_BV = 2560, C_BO = 3072, C_CX = 3584, C_CG = 5120, C_MG = 5632, C_SM = 8704;

constexpr size_t SZ_WIN = (size_t)DEPTH * NPROJ * DM * 2, SZ_WBR = (size_t)DEPTH * 3072 * 512 * 2, SZ_WOUT = (size_t)DEPTH * DM * DM * 2,
                 SZ_WF1 = (size_t)DEPTH * 2 * FFH * DM * 2, SZ_WF2 = (size_t)DEPTH * DM * FFH * 2, SZ_LB = DEPTH * 512 * 4;
constexpr size_t WS_WIN = 0, WS_WBR = WS_WIN + SZ_WIN, WS_WOUT = WS_WBR + SZ_WBR, WS_WF1 = WS_WOUT + SZ_WOUT, WS_WF2 = WS_WF1 + SZ_WF1, WS_LB = WS_WF2 + SZ_WF2;
constexpr size_t WS_H32 = WS_LB + SZ_LB, WS_P = WS_H32 + (size_t)T * DM * 4, WS_G = WS_P + (size_t)T * NPROJ * 2, WS_R1 = WS_G + (size_t)T * 16 * 4,
                 WS_R2 = WS_R1 + (size_t)T * 1536 * 2, WS_END = WS_R2 + (size_t)T * 1536 * 4;
constexpr size_t O_Y = 0, O_HA_P = (size_t)T * DM, O_HA_S = O_HA_P + (size_t)DEPTH * 8 * 4 * 16384, O_MC_P = O_HA_S + (size_t)DEPTH * 128 * 4 * 16384,
                 O_MC_S = O_MC_P + (size_t)DEPTH * 8 * 4 * 8192, O_MN_P = O_MC_S + (size_t)DEPTH * 128 * 4 * 8192, O_MN_S = O_MN_P + DEPTH * 8 * 4 * 64,
                 O_MM_P = O_MN_S + DEPTH * 128 * 4 * 64, O_MM_S = O_MM_P + DEPTH * 8 * 4, O_G_P = O_MM_S + DEPTH * 128 * 4, O_G_S = O_G_P + (size_t)DEPTH * 8 * 4 * 16384,
                 O_CV_P = O_G_S + (size_t)DEPTH * 128 * 4 * 16384, O_CV_S = O_CV_P + (size_t)DEPTH * 8 * 3 * 1536, O_END = O_CV_S + (size_t)DEPTH * 128 * 3 * 1536;

struct P { const float* in[26]; float* out; unsigned char* ws; int lo, hi; };
enum { I_XP = 0, I_XS, I_SA, I_SC, I_SN, I_SM, I_SG, I_SV, I_WIN, I_LB, I_ANG, I_BMI, I_BMF, I_BNG, I_CW, I_ALOG, I_DTB, I_CNG, I_WBR, I_WOUT, I_L1G, I_L1B, I_WF1, I_WF2, I_L2G, I_L2B };

__device__ __forceinline__ int my_tid() { int t = threadIdx.x; asm volatile("" : "+v"(t)); return t; }
__device__ __forceinline__ int my_bid() { int b = blockIdx.x; asm volatile("" : "+s"(b)); return b; }
__device__ __forceinline__ int my_grid() { int g = gridDim.x; asm volatile("" : "+s"(g)); return g; }
__device__ __forceinline__ float sigm(float x) { return __builtin_amdgcn_rcpf(1.0f + __expf(-x)); }
__device__ __forceinline__ float silu(float x) { return x * sigm(x); }
template <int CTRL> __device__ __forceinline__ float dppf(float x) { return __builtin_bit_cast(float, __builtin_amdgcn_mov_dpp(__builtin_bit_cast(int, x), CTRL, 0xf, 0xf, true)); }
__device__ __forceinline__ float red16(float x) { x += dppf<0xB1>(x); x += dppf<0x4E>(x); x += dppf<0x124>(x); x += dppf<0x128>(x); return x; }
__device__ __forceinline__ float red64(float x) { x = red16(x); x += __shfl_xor(x, 16); x += __shfl_xor(x, 32); return x; }

namespace pg8 {
constexpr int BM = 256, BK = 64, HALF = 128, HTB = HALF * BK * 2, STAGE_BYTES = 8 * HTB, NXCD = 8, WGM = 8;
__device__ __forceinline__ int lds_byte(int r, int c) { const int st = (r >> 4) * 2 + (c >> 5), rr = r & 15, cc = c & 31, ob = rr * 64 + cc * 2; return st * 1024 + (ob ^ (((ob >> 9) & 1) << 5)); }
__device__ __forceinline__ void stage_rc(int b, int& R, int& C) { const int st = b / 1024, sb = b % 1024, swz = sb ^ (((sb >> 9) & 1) << 5); R = (st >> 1) * 16 + swz / 64; C = (st & 1) * 32 + (swz % 64) / 2; }
__device__ __forceinline__ int perm32(int rho) { const int n = rho >> 4, i = rho & 15; return 8 * (i >> 2) + 4 * n + (i & 3); }
struct Unit { int pm, pn; };
struct Gemm { const h16* A; const h16* Bt; int M, N, K; };
struct StaticOrder {
    int nM, nN, nwg, G, c;
    __device__ void init(int M, int N, int G_, int c_) { nM = M / BM; nN = N / BM; nwg = nM * nN; G = G_; c = c_; }
    __device__ bool next(int i, Unit& u) const {
        const long L = (long)i * G + c; if (L >= nwg) return false;
        int wgid = (int)L; { const int q = nwg / NXCD, r = nwg % NXCD, xcd = wgid % NXCD, off = wgid / NXCD; wgid = (xcd < r ? xcd * (q + 1) : r * (q + 1) + (xcd - r) * q) + off; }
        const int nig = WGM * nN, gid = wgid / nig, fm = gid * WGM, gsz = (nM - fm) < WGM ? (nM - fm) : WGM;
        u.pm = fm + ((wgid % nig) % gsz); u.pn = (wgid % nig) / gsz; return true;
    }
};
struct BranchOrder {
    int G, c;
    __device__ bool next(int i, Unit& u) const {
        const int ti = i / 3, br = i - 3 * ti; const int tile = ti * G + c; if (tile >= 68 * 4) return false;
        u.pm = (tile >> 2) + 68 * br; u.pn = (tile & 3) + 4 * br; return true;
    }
};

template <class Epi, class Sched>
__device__ __forceinline__ void gemm_phase(LAS unsigned char* lds, const Gemm g, const Sched& S, const Epi& E) {
    const int tid = my_tid(), wid = __builtin_amdgcn_readfirstlane(tid >> 6), lane = tid & 63, wr = wid >> 2, wc = wid & 3, fr = lane & 15, fq = lane >> 4;
    const int K = g.K, nt = K / BK;
    unsigned voffA[2], voffB[2];
#pragma unroll
    for (int i = 0; i < 2; ++i) { int R, C; stage_rc(tid * 16 + i * 8192, R, C); const int Rb = Epi::PERM ? ((R & ~31) + perm32(R & 31)) : R;
        voffA[i] = (unsigned)(R * K + C) * 2u; voffB[i] = (unsigned)(Rb * K + C) * 2u; }
    const size_t kstep = (size_t)(BK * 2);
    const size_t hstep = (size_t)HALF * K * 2;
    const size_t tstep = 2 * hstep;
    const unsigned ldsw = (unsigned)wid * 1024u;
    const int aoff = lds_byte(wr * 64 + fr, fq * 8), boff = lds_byte(wc * 32 + fr, fq * 8);
#define PG8_SA(b, h) (((b) * 2 + (h)) * HTB)
#define PG8_SB(b, h) ((4 + (b) * 2 + (h)) * HTB)
#define PG8_STAGE(bufoff, gbase, voff) do { _Pragma("unroll") for (int _i = 0; _i < 2; ++_i) \
        __builtin_amdgcn_global_load_lds((const unsigned*)((const char*)(gbase) + (voff)[_i]), (LAS unsigned*)(lds + (bufoff) + ldsw + _i * 8192), 16, 0, 0); } while (0)
#define PG8_LDA(dst, b, h) do { _Pragma("unroll") for (int m = 0; m < 4; ++m) _Pragma("unroll") for (int k = 0; k < 2; ++k) dst[m][k] = *(const LAS h16x8*)(lds + PG8_SA(b, h) + aoff + m * 2048 + k * 1024); } while (0)
#define PG8_LDB(dst, b, h) do { _Pragma("unroll") for (int n = 0; n < 2; ++n) _Pragma("unroll") for (int k = 0; k < 2; ++k) dst[n][k] = *(const LAS h16x8*)(lds + PG8_SB(b, h) + boff + n * 2048 + k * 1024); } while (0)
#define PG8_MMA(ai, bj, At, Bt) do { __builtin_amdgcn_s_setprio(1); _Pragma("unroll") for (int m = 0; m < 4; ++m) _Pragma("unroll") for (int n = 0; n < 2; ++n) _Pragma("unroll") for (int k = 0; k < 2; ++k) \
        acc[ai][bj][m][n] = __builtin_amdgcn_mfma_f32_16x16x32_f16(Bt[n][k], At[m][k], acc[ai][bj][m][n], 0, 0, 0); __builtin_amdgcn_s_setprio(0); } while (0)
#define PG8_WAIT_V(n) asm volatile("s_waitcnt vmcnt(" #n ")" ::: "memory")
#define PG8_WAIT_L(n) asm volatile("s_waitcnt lgkmcnt(" #n ")" ::: "memory")
#define PG8_BAR __builtin_amdgcn_s_barrier()
#define PG8_SCHED __builtin_amdgcn_sched_barrier(0)
    Unit cur, nxt; int ui = 0;
    if (!S.next(0, cur)) return;
    f32x4 acc[2][2][4][2];
#pragma unroll
    for (int a = 0; a < 2; ++a)
#pragma unroll
        for (int b = 0; b < 2; ++b)
#pragma unroll
            for (int m = 0; m < 4; ++m)
#pragma unroll
                for (int n = 0; n < 2; ++n) acc[a][b][m][n] = (f32x4){0.f, 0.f, 0.f, 0.f};
    h16x8 At[4][2], B0[2][2], B1[2][2];
    const char* cA = (const char*)g.A + (size_t)cur.pm * tstep; const char* cB = (const char*)g.Bt + (size_t)cur.pn * tstep;
    PG8_STAGE(PG8_SB(0, 0), cB, voffB); PG8_STAGE(PG8_SA(0, 0), cA, voffA); PG8_STAGE(PG8_SB(0, 1), cB + hstep, voffB); PG8_STAGE(PG8_SA(0, 1), cA + hstep, voffA);
    if (wr == 1) PG8_BAR;
    PG8_WAIT_V(4); PG8_BAR;
    PG8_STAGE(PG8_SB(1, 0), cB + kstep, voffB); PG8_STAGE(PG8_SA(1, 0), cA + kstep, voffA); PG8_STAGE(PG8_SB(1, 1), cB + hstep + kstep, voffB);
    PG8_WAIT_V(6); PG8_BAR;
    for (;;) {
        const bool has_next = S.next(ui + 1, nxt);
        const char* nA = has_next ? (const char*)g.A + (size_t)nxt.pm * tstep : cA; const char* nB = has_next ? (const char*)g.Bt + (size_t)nxt.pn * tstep : cB;
        for (int t = 0; t < nt; t += 2) {
            const bool last = (t == nt - 2);
            const char* a1 = cA + (size_t)(t + 1) * kstep;
            const char* a2 = last ? nA : cA + (size_t)(t + 2) * kstep; const char* b2 = last ? nB : cB + (size_t)(t + 2) * kstep;
            const char* a3 = a2 + kstep; const char* b3 = b2 + kstep;
            PG8_LDB(B0, 0, 0); PG8_SCHED; PG8_LDA(At, 0, 0); PG8_STAGE(PG8_SA(1, 1), a1 + hstep, voffA);
            PG8_WAIT_L(8); PG8_BAR; PG8_WAIT_L(0); PG8_MMA(0, 0, At, B0); PG8_BAR; PG8_SCHED;
            PG8_LDB(B1, 0, 1); PG8_STAGE(PG8_SB(0, 0), b2, voffB);
            PG8_BAR; PG8_WAIT_L(0); PG8_MMA(0, 1, At, B1); PG8_BAR;
            PG8_LDA(At, 0, 1); PG8_STAGE(PG8_SA(0, 0), a2, voffA);
            PG8_BAR; PG8_WAIT_L(0); PG8_MMA(1, 0, At, B0); PG8_BAR; PG8_SCHED;
            PG8_STAGE(PG8_SB(0, 1), b2 + hstep, voffB);
            PG8_WAIT_V(6); PG8_BAR; PG8_MMA(1, 1, At, B1); PG8_BAR;
            PG8_LDB(B0, 1, 0); PG8_SCHED; PG8_LDA(At, 1, 0); PG8_STAGE(PG8_SA(0, 1), a2 + hstep, voffA);
            PG8_WAIT_L(8); PG8_BAR; PG8_WAIT_L(0); PG8_MMA(0, 0, At, B0); PG8_BAR; PG8_SCHED;
            PG8_LDB(B1, 1, 1); PG8_STAGE(PG8_SB(1, 0), b3, voffB);
            PG8_BAR; PG8_WAIT_L(0); PG8_MMA(0, 1, At, B1); PG8_BAR;
            PG8_LDA(At, 1, 1); PG8_STAGE(PG8_SA(1, 0), a3, voffA);
            PG8_BAR; PG8_WAIT_L(0); PG8_MMA(1, 0, At, B0); PG8_BAR; PG8_SCHED;
            PG8_STAGE(PG8_SB(1, 1), b3 + hstep, voffB);
            PG8_WAIT_V(6); PG8_BAR; PG8_MMA(1, 1, At, B1); PG8_BAR;
        }
        E(acc, cur, wr, wc, fr, fq);
        if (!has_next) break;
#pragma unroll
        for (int a = 0; a < 2; ++a)
#pragma unroll
            for (int b = 0; b < 2; ++b)
#pragma unroll
                for (int m = 0; m < 4; ++m)
#pragma unroll
                    for (int n = 0; n < 2; ++n) acc[a][b][m][n] = (f32x4){0.f, 0.f, 0.f, 0.f};
        cur = nxt; cA = nA; cB = nB; ++ui;
    }
    PG8_WAIT_V(0);
    if (wr == 0) PG8_BAR;
    PG8_BAR;
#undef PG8_SA
#undef PG8_SB
#undef PG8_STAGE
#undef PG8_LDA
#undef PG8_LDB
#undef PG8_MMA
#undef PG8_WAIT_V
#undef PG8_WAIT_L
#undef PG8_BAR
#undef PG8_SCHED
}
}
using pg8::Unit;

__device__ __forceinline__ h16x8 pack8(const f32x4 a, const f32x4 b) {
    h16x8 o; o[0] = (h16)a[0]; o[1] = (h16)a[1]; o[2] = (h16)a[2]; o[3] = (h16)a[3]; o[4] = (h16)b[0]; o[5] = (h16)b[1]; o[6] = (h16)b[2]; o[7] = (h16)b[3]; return o;
}

struct EpiIn {
    static constexpr bool PERM = true;
    h16* proj; float* gates; const float* lb; const float* b_mi; const float* b_mf; const float* a_log; const float* dt_bias;
    __device__ __forceinline__ void operator()(const f32x4 (&acc)[2][2][4][2], const Unit& u, int wr, int wc, int fr, int fq) const {
        const int pn = u.pn; const int row0 = u.pm * 256 + wr * 64 + fr;
        if (pn == 34) {
            if (wc == 0 && fq < 2) {
                f32x4 c0, c1;
                if (fq == 0) { c0 = *(const f32x4*)b_mi; c1 = *(const f32x4*)b_mf; } else { c0 = *(const f32x4*)a_log; c1 = *(const f32x4*)dt_bias; }
#pragma unroll
                for (int ai = 0; ai < 2; ++ai)
#pragma unroll
                    for (int m = 0; m < 4; ++m) {
                        const f32x4 x0 = acc[ai][0][m][0], x1 = acc[ai][0][m][1]; f32x4 y0, y1;
#pragma unroll
                        for (int j = 0; j < 4; ++j) {
                            if (fq == 0) { y0[j] = x0[j] + c0[j]; const float z = x1[j] + c1[j]; y1[j] = fminf(z, 0.f) - log1pf(__expf(-fabsf(z))); }
                            else { y0[j] = sigm(x0[j]); const float z = x1[j] + c1[j]; y1[j] = -__expf(c0[j]) * (fmaxf(z, 0.f) + log1pf(__expf(-fabsf(z)))); }
                        }
                        float* gp = gates + (size_t)(row0 + ai * 128 + m * 16) * 16 + 8 * fq;
                        *(f32x4*)gp = y0; *(f32x4*)(gp + 4) = y1;
                    }
            }
            return;
        }
        int mode = 0;
        if (pn < 2) mode = 1; else if (pn < 4) mode = 3; else if (pn < 6) mode = 0; else if (pn < 8) mode = 1; else if (pn == 8) mode = 4; else if (pn < 12) mode = 0;
        else if (pn < 14) mode = 2; else if (pn < 20) mode = 0; else if (pn < 22) mode = 1; else mode = 2;
        const int col0 = pn * 256 + wc * 32 + 8 * fq;
        f32x4 lbv[2][2];
        if (mode == 3) {
#pragma unroll
            for (int bj = 0; bj < 2; ++bj)
#pragma unroll
                for (int n = 0; n < 2; ++n) lbv[bj][n] = 1.0f - *(const f32x4*)(lb + (col0 - C_AF) + bj * 128 + 4 * n);
        }
#pragma unroll
        for (int ai = 0; ai < 2; ++ai)
#pragma unroll
            for (int m = 0; m < 4; ++m) {
                h16* rowp = proj + (size_t)(row0 + ai * 128 + m * 16) * NPROJ + col0;
#pragma unroll
                for (int bj = 0; bj < 2; ++bj) {
                    f32x4 v[2] = {acc[ai][bj][m][0], acc[ai][bj][m][1]};
                    if (mode == 1) { for (int n = 0; n < 2; ++n) for (int j = 0; j < 4; ++j) v[n][j] = silu(v[n][j]); }
                    else if (mode == 2) { for (int n = 0; n < 2; ++n) for (int j = 0; j < 4; ++j) v[n][j] = sigm(v[n][j]); }
                    else if (mode == 3) { for (int n = 0; n < 2; ++n) for (int j = 0; j < 4; ++j) v[n][j] = lbv[bj][n][j] * sigm(-v[n][j]); }
                    else if (mode == 4) { v[0] *= 0.125f; v[1] *= 0.125f; }
                    *(h16x8*)(rowp + bj * 128) = pack8(v[0], v[1]);
                }
            }
    }
};
struct EpiBranch {
    static constexpr bool PERM = true;
    const h16* proj; float* mrg32; h16* mrg16;
    __device__ __forceinline__ void operator()(const f32x4 (&acc)[2][2][4][2], const Unit& u, int wr, int wc, int fr, int fq) const {
        const int br = u.pn >> 2; const int pn = u.pn & 3, pm = u.pm - 68 * br;
        const int row0 = pm * 256 + wr * 64 + fr, col0 = pn * 256 + wc * 32 + 8 * fq;
#pragma unroll
        for (int ai = 0; ai < 2; ++ai)
#pragma unroll
            for (int m = 0; m < 4; ++m) {
                const size_t row = (size_t)(row0 + ai * 128 + m * 16);
#pragma unroll
                for (int bj = 0; bj < 2; ++bj) {
                    const h16x8 gt = *(const h16x8*)(proj + row * NPROJ + C_MG + br * 1024 + col0 + bj * 128);
                    float* mp = mrg32 + row * DM + col0 + bj * 128;
                    f32x4 v0 = acc[ai][bj][m][0], v1 = acc[ai][bj][m][1];
#pragma unroll
                    for (int j = 0; j < 4; ++j) { v0[j] *= (float)gt[j]; v1[j] *= (float)gt[4 + j]; }
                    if (br > 0) { v0 += *(const f32x4*)mp; v1 += *(const f32x4*)(mp + 4); }
                    if (br < 2) { *(f32x4*)mp = v0; *(f32x4*)(mp + 4) = v1; }
                    else *(h16x8*)(mrg16 + row * DM + col0 + bj * 128) = pack8(v0, v1);
                }
            }
    }
};
struct EpiRes {
    static constexpr bool PERM = false;
    const float* h32; float* pre32;
    __device__ __forceinline__ void operator()(const f32x4 (&acc)[2][2][4][2], const Unit& u, int wr, int wc, int fr, int fq) const {
        const int row0 = u.pm * 256 + wr * 64 + fr, col0 = u.pn * 256 + wc * 32 + 4 * fq;
#pragma unroll
        for (int ai = 0; ai < 2; ++ai)
#pragma unroll
            for (int m = 0; m < 4; ++m) {
                const size_t off = (size_t)(row0 + ai * 128 + m * 16) * DM + col0;
#pragma unroll
                for (int bj = 0; bj < 2; ++bj)
#pragma unroll
                    for (int n = 0; n < 2; ++n) { const f32x4 hv = *(const f32x4*)(h32 + off + bj * 128 + n * 16); *(f32x4*)(pre32 + off + bj * 128 + n * 16) = ALPHA * hv + acc[ai][bj][m][n]; }
            }
    }
};
struct EpiSwiglu {
    static constexpr bool PERM = true;
    h16* ff;
    __device__ __forceinline__ void operator()(const f32x4 (&acc)[2][2][4][2], const Unit& u, int wr, int wc, int fr, int fq) const {
        const int row0 = u.pm * 256 + wr * 64 + fr, col0 = u.pn * 128 + wc * 32 + 8 * fq;
#pragma unroll
        for (int ai = 0; ai < 2; ++ai)
#pragma unroll
            for (int m = 0; m < 4; ++m) {
                f32x4 v[2];
#pragma unroll
                for (int n = 0; n < 2; ++n)
#pragma unroll
                    for (int j = 0; j < 4; ++j) v[n][j] = silu(acc[ai][0][m][n][j]) * acc[ai][1][m][n][j];
                *(h16x8*)(ff + (size_t)(row0 + ai * 128 + m * 16) * FFH + col0) = pack8(v[0], v[1]);
            }
    }
};

__device__ __forceinline__ int map_in(int n) {
    if (n < 3584) return n;
    if (n < 5632) return n + 8;
    if (n < 8704) return n + 16;
    if (n < 8708) return 3584 + (n - 8704);
    if (n < 8712) return 3588 + (n - 8708);
    if (n < 8716) return 5640 + (n - 8712);
    if (n < 8720) return 5644 + (n - 8716);
    return -1;
}
__device__ __forceinline__ int map_f1(int n) { const int p = n >> 8, w = n & 255; return w < 128 ? 128 * p + w : FFH + 128 * p + (w - 128); }
__device__ __forceinline__ void tr_tile(const float* __restrict__ src, int Nsrc, h16* __restrict__ dst, int K, int n0, int k0, int mapid, LAS float* tile) {
    const int tid = my_tid(), tx = tid & 63, ty = tid >> 6;
    const int n = n0 + tx; const int sc = mapid == 0 ? n : (mapid == 1 ? map_in(n) : map_f1(n));
#pragma unroll
    for (int p = 0; p < 8; ++p) { const int k = ty + 8 * p; tile[k * 65 + tx] = sc >= 0 ? src[(size_t)(k0 + k) * Nsrc + sc] : 0.f; }
    __syncthreads();
    const int kx = (tid & 31) * 2, ny = tid >> 5;
#pragma unroll
    for (int p = 0; p < 4; ++p) { const int nn = ny + 16 * p; h16x2 o; o[0] = (h16)tile[kx * 65 + nn]; o[1] = (h16)tile[(kx + 1) * 65 + nn]; *(h16x2*)(dst + (size_t)(n0 + nn) * K + k0 + kx) = o; }
    __syncthreads();
}
__device__ void phase_prep(const P& p, LAS unsigned char* lds) {
    LAS float* tile = (LAS float*)lds;
    unsigned char* ws = p.ws;
    constexpr int T_IN = (NPROJ / 64) * (DM / 64), T_BR = 3 * (1024 / 64) * (512 / 64), T_OUT = 16 * 16, T_F1 = (2 * FFH / 64) * 16, T_F2 = 16 * (FFH / 64), T_L = T_IN + T_BR + T_OUT + T_F1 + T_F2;
    for (int id = my_bid(); id < DEPTH * T_L; id += my_grid()) {
        const int l = id / T_L; int r = id - l * T_L;
        if (r < T_IN) { const int tn = r / 16, tk = r % 16; tr_tile(p.in[I_WIN] + (size_t)l * DM * NSRC_IN, NSRC_IN, (h16*)(ws + WS_WIN) + (size_t)l * NPROJ * DM, DM, tn * 64, tk * 64, 1, tile); continue; }
        r -= T_IN;
        if (r < T_BR) { const int br = r / 128, q = r % 128, tn = q / 8, tk = q % 8; tr_tile(p.in[I_WBR] + ((size_t)l * 3 + br) * 512 * 1024, 1024, (h16*)(ws + WS_WBR) + ((size_t)l * 3 + br) * 1024 * 512, 512, tn * 64, tk * 64, 0, tile); continue; }
        r -= T_BR;
        if (r < T_OUT) { const int tn = r / 16, tk = r % 16; tr_tile(p.in[I_WOUT] + (size_t)l * DM * DM, DM, (h16*)(ws + WS_WOUT) + (size_t)l * DM * DM, DM, tn * 64, tk * 64, 0, tile); continue; }
        r -= T_OUT;
        if (r < T_F1) { const int tn = r / 16, tk = r % 16; tr_tile(p.in[I_WF1] + (size_t)l * DM * 2 * FFH, 2 * FFH, (h16*)(ws + WS_WF1) + (size_t)l * 2 * FFH * DM, DM, tn * 64, tk * 64, 2, tile); continue; }
        r -= T_F1;
        { const int tn = r / (FFH / 64), tk = r % (FFH / 64); tr_tile(p.in[I_WF2] + (size_t)l * FFH * DM, DM, (h16*)(ws + WS_WF2) + (size_t)l * DM * FFH, FFH, tn * 64, tk * 64, 0, tile); }
    }
    if (my_bid() == 0) {
        const int c = my_tid(); const float* lg = p.in[I_LB];
        const float a0 = lg[c], a1 = lg[512 + c], a2 = lg[1024 + c], a3 = lg[1536 + c]; const float mx = fmaxf(fmaxf(a0, a1), fmaxf(a2, a3));
        const float e0 = expf(a0 - mx), e1 = expf(a1 - mx), e2 = expf(a2 - mx), e3 = expf(a3 - mx), inv = 1.0f / (e0 + e1 + e2 + e3);
        float* lb = (float*)(ws + WS_LB); lb[c] = 0.f; lb[512 + c] = e1 * inv; lb[1024 + c] = (e1 + e2) * inv; lb[1536 + c] = (e1 + e2 + e3) * inv;
    }
    float* h32 = (float*)(ws + WS_H32); h16* hh = (h16*)(ws + WS_R1);
    const size_t n4 = (size_t)T * DM / 4, np4 = (size_t)TP * DM / 4;
    for (size_t i = (size_t)my_bid() * NTHREADS + my_tid(); i < n4; i += (size_t)my_grid() * NTHREADS) {
        const f32x4 v = i < np4 ? ((const f32x4*)p.in[I_XP])[i] : ((const f32x4*)p.in[I_XS])[i - np4];
        ((f32x4*)h32)[i] = v; h16x4 o; o[0] = (h16)v[0]; o[1] = (h16)v[1]; o[2] = (h16)v[2]; o[3] = (h16)v[3]; ((h16x4*)hh)[i] = o;
    }
}

__device__ void phase_conv(const P& p, int l) {
    const int lane = my_tid() & 63, wv = my_tid() >> 6, seg = lane & 15, hg = lane >> 4;
    const h16* proj = (const h16*)(p.ws + WS_P); h16* cprep = (h16*)(p.ws + WS_R1);
    const float* cw = p.in[I_CW] + (size_t)l * 4 * 1536;
    for (int r = my_bid() + my_grid() * wv; r < T; r += my_grid() * NWAVES) {
        int b, pos, L, grp; if (r < TP) { grp = 0; b = r >> 11; pos = r & 2047; L = 2048; } else { grp = 1; b = (r - TP) >> 3; pos = (r - TP) & 7; L = 8; }
#pragma unroll 1
        for (int it = 0; it < 3; ++it) {
            const int c = it * 512 + hg * 128 + seg * 8;
            float a[8];
#pragma unroll
            for (int j = 0; j < 8; ++j) a[j] = 0.f;
            h16x8 xc;
#pragma unroll
            for (int d = 0; d < 4; ++d) {
                float xv[8]; bool have = true;
                if (pos - d >= 0) { const h16x8 x = *(const h16x8*)(proj + (size_t)(r - d) * NPROJ + C_CX + c); if (d == 0) xc = x;
#pragma unroll
                    for (int j = 0; j < 8; ++j) xv[j] = (float)x[j]; }
                else if (grp) { const float* sp = p.in[I_SV] + (((size_t)l * 128 + b) * 3 + (3 + pos - d)) * 1536 + c; const f32x4 s0 = *(const f32x4*)sp, s1 = *(const f32x4*)(sp + 4);
#pragma unroll
                    for (int j = 0; j < 4; ++j) { xv[j] = s0[j]; xv[4 + j] = s1[j]; } }
                else have = false;
                if (have) { const f32x4 w0 = *(const f32x4*)(cw + (3 - d) * 1536 + c), w1 = *(const f32x4*)(cw + (3 - d) * 1536 + c + 4);
#pragma unroll
                    for (int j = 0; j < 4; ++j) { a[j] += xv[j] * w0[j]; a[4 + j] += xv[4 + j] * w1[j]; } }
            }
            float ss = 0.f;
#pragma unroll
            for (int j = 0; j < 8; ++j) { a[j] = silu(a[j]); ss += a[j] * a[j]; }
            if (it < 2) { ss = red16(ss); const float sc = rsqrtf(ss + 1e-6f) * (it == 0 ? 0.08838834764831845f : 1.0f);
#pragma unroll
                for (int j = 0; j < 8; ++j) a[j] *= sc; }
            h16x8 o;
#pragma unroll
            for (int j = 0; j < 8; ++j) o[j] = (h16)a[j];
            *(h16x8*)(cprep + (size_t)r * 1536 + c) = o;
            if (pos >= L - 3) {
                float* op = p.out + (grp ? O_CV_S + (((size_t)l * 128 + b) * 3 + (pos - (L - 3))) * 1536 : O_CV_P + (((size_t)l * 8 + b) * 3 + (pos - (L - 3))) * 1536) + c;
                f32x4 o0, o1;
#pragma unroll
                for (int j = 0; j < 4; ++j) { o0[j] = (float)xc[j]; o1[j] = (float)xc[4 + j]; }
                *(f32x4*)op = o0; *(f32x4*)(op + 4) = o1;
            }
        }
    }
}

template <int NC> __device__ __forceinline__ void ld_h(const h16* p, float (&v)[NC]) {
    if constexpr (NC == 2) { const h16x2 x = *(const h16x2*)p; v[0] = (float)x[0]; v[1] = (float)x[1]; }
    else { const h16x8 x = *(const h16x8*)p;
#pragma unroll
        for (int j = 0; j < 8; ++j) v[j] = (float)x[j]; }
}
template <int NC> __device__ __forceinline__ void st_f(float* p, const float (&v)[NC]) {
    if constexpr (NC == 2) { *(f32x2*)p = (f32x2){v[0], v[1]}; }
    else { *(f32x4*)p = (f32x4){v[0], v[1], v[2], v[3]}; *(f32x4*)(p + 4) = (f32x4){v[4], v[5], v[6], v[7]}; }
}
template <int NC> __device__ __forceinline__ void ld_f(const float* p, float (&v)[NC]) {
    if constexpr (NC == 2) { const f32x2 x = *(const f32x2*)p; v[0] = x[0]; v[1] = x[1]; }
    else { const f32x4 x = *(const f32x4*)p, y = *(const f32x4*)(p + 4);
#pragma unroll
        for (int j = 0; j < 4; ++j) { v[j] = x[j]; v[4 + j] = y[j]; } }
}

template <int NC> __device__ void scanA(const P& p, int l, int grp, int b, int h, int unit, int lane) {
    const int seg = lane & 15, cgp = lane >> 4; const int L = grp ? 8 : 2048; const size_t row0 = grp ? (size_t)TP + b * 8 : (size_t)b * 2048;
    const int c0 = unit * (4 * NC) + cgp * NC;
    float S[8][NC];
    const size_t sidx = (size_t)h * 16384 + (size_t)(8 * seg) * 128 + c0;
    if (grp) { const float* sp = p.in[I_SA] + ((size_t)l * 128 + b) * 65536 + sidx;
#pragma unroll
        for (int r = 0; r < 8; ++r) ld_f<NC>(sp + r * 128, S[r]); }
    else {
#pragma unroll
        for (int r = 0; r < 8; ++r)
#pragma unroll
            for (int j = 0; j < NC; ++j) S[r][j] = 0.f; }
    const h16* base = (const h16*)(p.ws + WS_P) + row0 * NPROJ + h * 128;
    float* ob = (float*)(p.ws + WS_R2) + row0 * 1536 + h * 128 + c0;
    h16x8 qn = *(const h16x8*)(base + C_AQ + 8 * seg), kn = *(const h16x8*)(base + C_AF + 8 * seg); float vn[NC]; ld_h<NC>(base + C_AI + c0, vn);
#pragma unroll 1
    for (int t = 0; t < L; ++t) {
        const h16x8 q8 = qn, k8 = kn; float v[NC];
#pragma unroll
        for (int j = 0; j < NC; ++j) v[j] = vn[j];
        if (t + 1 < L) { const h16* nb = base + (size_t)(t + 1) * NPROJ; qn = *(const h16x8*)(nb + C_AQ + 8 * seg); kn = *(const h16x8*)(nb + C_AF + 8 * seg); ld_h<NC>(nb + C_AI + c0, vn); }
        float o[NC];
#pragma unroll
        for (int j = 0; j < NC; ++j) o[j] = 0.f;
#pragma unroll
        for (int r = 0; r < 8; ++r) { const float kk = (float)k8[r], qq = (float)q8[r];
#pragma unroll
            for (int j = 0; j < NC; ++j) { S[r][j] += kk * (v[j] - S[r][j]); o[j] += S[r][j] * qq; } }
#pragma unroll
        for (int j = 0; j < NC; ++j) o[j] = red16(o[j]);
        if (seg == 0) st_f<NC>(ob + (size_t)t * 1536, o);
    }
    float* op = p.out + (grp ? O_HA_S + ((size_t)l * 128 + b) * 65536 : O_HA_P + ((size_t)l * 8 + b) * 65536) + sidx;
#pragma unroll
    for (int r = 0; r < 8; ++r) st_f<NC>(op + r * 128, S[r]);
}
template <int NC> __device__ void scanC(const P& p, int l, int grp, int b, int h, int unit, int lane) {
    const int seg = lane & 15, cgp = lane >> 4; const int L = grp ? 8 : 2048; const size_t row0 = grp ? (size_t)TP + b * 8 : (size_t)b * 2048;
    const int c0 = unit * (4 * NC) + cgp * NC;
    float S[8][NC];
    const size_t sidx = (size_t)h * 16384 + (size_t)(8 * seg) * 128 + c0;
    if (grp) { const float* sp = p.in[I_SG] + ((size_t)l * 128 + b) * 65536 + sidx;
#pragma unroll
        for (int r = 0; r < 8; ++r) ld_f<NC>(sp + r * 128, S[r]); }
    else {
#pragma unroll
        for (int r = 0; r < 8; ++r)
#pragma unroll
            for (int j = 0; j < NC; ++j) S[r][j] = 0.f; }
    const h16* base = (const h16*)(p.ws + WS_R1) + row0 * 1536 + h * 128;
    const float* gt = (const float*)(p.ws + WS_G) + row0 * 16 + h;
    float* ob = (float*)(p.ws + WS_R2) + row0 * 1536 + 1024 + h * 128 + c0;
    h16x8 qn = *(const h16x8*)(base + 8 * seg), kn = *(const h16x8*)(base + 512 + 8 * seg); float vn[NC]; ld_h<NC>(base + 1024 + c0, vn);
    float betan = gt[8], gn = gt[12];
#pragma unroll 1
    for (int t = 0; t < L; ++t) {
        const h16x8 q8 = qn, k8 = kn; float v[NC]; const float beta = betan, a = __expf(gn);
#pragma unroll
        for (int j = 0; j < NC; ++j) v[j] = vn[j];
        if (t + 1 < L) { const h16* nb = base + (size_t)(t + 1) * 1536; qn = *(const h16x8*)(nb + 8 * seg); kn = *(const h16x8*)(nb + 512 + 8 * seg); ld_h<NC>(nb + 1024 + c0, vn);
            betan = gt[(size_t)(t + 1) * 16 + 8]; gn = gt[(size_t)(t + 1) * 16 + 12]; }
        float kf[8], qf[8];
#pragma unroll
        for (int r = 0; r < 8; ++r) { kf[r] = (float)k8[r]; qf[r] = (float)q8[r]; }
        float u[NC];
#pragma unroll
        for (int j = 0; j < NC; ++j) u[j] = 0.f;
#pragma unroll
        for (int r = 0; r < 8; ++r)
#pragma unroll
            for (int j = 0; j < NC; ++j) u[j] += S[r][j] * kf[r];
        float o[NC];
#pragma unroll
        for (int j = 0; j < NC; ++j) { u[j] = red16(u[j]); u[j] = beta * (v[j] - a * u[j]); o[j] = 0.f; }
#pragma unroll
        for (int r = 0; r < 8; ++r)
#pragma unroll
            for (int j = 0; j < NC; ++j) { S[r][j] = a * S[r][j] + kf[r] * u[j]; o[j] += S[r][j] * qf[r]; }
#pragma unroll
        for (int j = 0; j < NC; ++j) o[j] = red16(o[j]);
        if (seg == 0) st_f<NC>(ob + (size_t)t * 1536, o);
    }
    float* op = p.out + (grp ? O_G_S + ((size_t)l * 128 + b) * 65536 : O_G_P + ((size_t)l * 8 + b) * 65536) + sidx;
#pragma unroll
    for (int r = 0; r < 8; ++r) st_f<NC>(op + r * 128, S[r]);
}
template <int NV> __device__ void scanB(const P& p, int l, int grp, int b, int h, int unit, int lane) {
    const int seg = lane & 15, vg = lane >> 4; const int L = grp ? 8 : 2048; const size_t row0 = grp ? (size_t)TP + b * 8 : (size_t)b * 2048;
    const int v0 = unit * (4 * NV) + vg * NV;
    float C[NV][4], nn[4], m;
    const size_t cidx = (size_t)h * 8192 + (size_t)v0 * 64 + 4 * seg;
    if (grp) { const float* sp = p.in[I_SC] + ((size_t)l * 128 + b) * 32768 + cidx;
#pragma unroll
        for (int i = 0; i < NV; ++i) { const f32x4 x = *(const f32x4*)(sp + i * 64); C[i][0] = x[0]; C[i][1] = x[1]; C[i][2] = x[2]; C[i][3] = x[3]; }
        const f32x4 x = *(const f32x4*)(p.in[I_SN] + (((size_t)l * 128 + b) * 4 + h) * 64 + 4 * seg); nn[0] = x[0]; nn[1] = x[1]; nn[2] = x[2]; nn[3] = x[3];
        m = p.in[I_SM][((size_t)l * 128 + b) * 4 + h]; }
    else {
#pragma unroll
        for (int i = 0; i < NV; ++i) { C[i][0] = 0.f; C[i][1] = 0.f; C[i][2] = 0.f; C[i][3] = 0.f; }
        nn[0] = nn[1] = nn[2] = nn[3] = 0.f; m = 0.f; }
    const h16* base = (const h16*)(p.ws + WS_P) + row0 * NPROJ;
    const float* gt = (const float*)(p.ws + WS_G) + row0 * 16 + h;
    float* ob = (float*)(p.ws + WS_R2) + row0 * 1536 + 512 + h * 128 + v0;
    h16x4 qn = *(const h16x4*)(base + C_BQ + h * 64 + 4 * seg), kn = *(const h16x4*)(base + C_BK + h * 64 + 4 * seg); float vn[NV]; ld_h<NV>(base + C_BV + h * 128 + v0, vn);
    float ign = gt[0], lfn = gt[4];
#pragma unroll 1
    for (int t = 0; t < L; ++t) {
        const h16x4 q4 = qn, k4 = kn; float v[NV]; const float ig = ign, lf = lfn;
#pragma unroll
        for (int i = 0; i < NV; ++i) v[i] = vn[i];
        if (t + 1 < L) { const h16* nb = base + (size_t)(t + 1) * NPROJ; qn = *(const h16x4*)(nb + C_BQ + h * 64 + 4 * seg); kn = *(const h16x4*)(nb + C_BK + h * 64 + 4 * seg); ld_h<NV>(nb + C_BV + h * 128 + v0, vn);
            ign = gt[(size_t)(t + 1) * 16]; lfn = gt[(size_t)(t + 1) * 16 + 4]; }
        const float mn = fmaxf(lf + m, ig), wo = __expf(lf + m - mn), wi = __expf(ig - mn); m = mn;
        float kf[4], qf[4];
#pragma unroll
        for (int r = 0; r < 4; ++r) { kf[r] = (float)k4[r]; qf[r] = (float)q4[r]; }
        float den = 0.f;
#pragma unroll
        for (int r = 0; r < 4; ++r) { nn[r] = wo * nn[r] + wi * kf[r]; den += nn[r] * qf[r]; }
        float num[NV];
#pragma unroll
        for (int i = 0; i < NV; ++i) { const float wv = wi * v[i]; num[i] = 0.f;
#pragma unroll
            for (int r = 0; r < 4; ++r) { C[i][r] = wo * C[i][r] + wv * kf[r]; num[i] += C[i][r] * qf[r]; } }
        den = red16(den);
        const float inv = 1.0f / fmaxf(fabsf(den), __expf(-m));
#pragma unroll
        for (int i = 0; i < NV; ++i) num[i] = red16(num[i]) * inv;
        if (seg == 0) st_f<NV>(ob + (size_t)t * 1536, num);
    }
    float* op = p.out + (grp ? O_MC_S + ((size_t)l * 128 + b) * 32768 : O_MC_P + ((size_t)l * 8 + b) * 32768) + cidx;
#pragma unroll
    for (int i = 0; i < NV; ++i) *(f32x4*)(op + i * 64) = (f32x4){C[i][0], C[i][1], C[i][2], C[i][3]};
    if (unit == 0 && vg == 0) {
        const size_t bh = grp ? ((size_t)l * 128 + b) * 4 + h : ((size_t)l * 8 + b) * 4 + h;
        *(f32x4*)(p.out + (grp ? O_MN_S : O_MN_P) + bh * 64 + 4 * seg) = (f32x4){nn[0], nn[1], nn[2], nn[3]};
        if (seg == 0) p.out[(grp ? O_MM_S : O_MM_P) + bh] = m;
    }
}
__device__ __forceinline__ void cvt8(const h16x8 x, LAS float* d) {
    *(LAS f32x4*)d = (f32x4){(float)x[0], (float)x[1], (float)x[2], (float)x[3]}; *(LAS f32x4*)(d + 4) = (f32x4){(float)x[4], (float)x[5], (float)x[6], (float)x[7]};
}
constexpr int PB = 8, NPB = 2048 / PB;
struct PScanA {
    static constexpr int REC = 272;
    struct Stg { h16x8 q[2], k[2], v; };
    const h16* base; int lane, seg, cgp; f32x2 S[8][2]; float* ob;
    __device__ __forceinline__ void init(const P& p, int l, int b, int h, int unit, int lane_) {
        lane = lane_; seg = lane & 15; cgp = lane >> 4;
        base = (const h16*)(p.ws + WS_P) + (size_t)b * 2048 * NPROJ + h * 128; ob = (float*)(p.ws + WS_R2) + (size_t)b * 2048 * 1536 + h * 128 + unit * 16 + cgp * 4;
        base += unit * 16;
#pragma unroll
        for (int r = 0; r < 8; ++r) { S[r][0] = (f32x2){0.f, 0.f}; S[r][1] = (f32x2){0.f, 0.f}; }
        u16 = unit * 16;
    }
    int u16;
    __device__ __forceinline__ void issue(int blk, Stg& s) const {
        blk = blk < NPB ? blk : NPB - 1;
#pragma unroll
        for (int i = 0; i < 2; ++i) { const h16* rp = base - u16 + (size_t)(blk * PB + (lane >> 4) + 4 * i) * NPROJ + (lane & 15) * 8; s.q[i] = *(const h16x8*)(rp + C_AQ); s.k[i] = *(const h16x8*)(rp + C_AF); }
        if (lane < 16) s.v = *(const h16x8*)(base + (size_t)(blk * PB + (lane >> 1)) * NPROJ + C_AI + (lane & 1) * 8);
    }
    __device__ __forceinline__ void write(const Stg& s, LAS float* slot) const {
#pragma unroll
        for (int i = 0; i < 2; ++i) { LAS float* d = slot + ((lane >> 4) + 4 * i) * REC + (lane & 15) * 8; cvt8(s.q[i], d); cvt8(s.k[i], d + 128); }
        if (lane < 16) cvt8(s.v, slot + (lane >> 1) * REC + 256 + (lane & 1) * 8);
    }
    __device__ __forceinline__ void step(const LAS float* rec, int t) {
        const f32x4 q0 = *(const LAS f32x4*)(rec + 4 * seg), q1 = *(const LAS f32x4*)(rec + 64 + 4 * seg), k0 = *(const LAS f32x4*)(rec + 128 + 4 * seg), k1 = *(const LAS f32x4*)(rec + 192 + 4 * seg);
        const f32x4 v4 = *(const LAS f32x4*)(rec + 256 + 4 * cgp);
        const f32x2 va = {v4[0], v4[1]}, vb = {v4[2], v4[3]};
        f32x2 oa = {0.f, 0.f}, obb = {0.f, 0.f};
#pragma unroll
        for (int r = 0; r < 8; ++r) { const float kk = r < 4 ? k0[r & 3] : k1[r & 3], qq = r < 4 ? q0[r & 3] : q1[r & 3];
            S[r][0] = S[r][0] + kk * (va - S[r][0]); S[r][1] = S[r][1] + kk * (vb - S[r][1]); oa = oa + S[r][0] * qq; obb = obb + S[r][1] * qq; }
        f32x4 o = {red16(oa[0]), red16(oa[1]), red16(obb[0]), red16(obb[1])};
        if (seg == 0) *(f32x4*)(ob + (size_t)t * 1536) = o;
    }
    __device__ __forceinline__ void finish(const P& p, int l, int b, int h, int unit) const {
        float* op = p.out + O_HA_P + (((size_t)l * 8 + b) * 4 + h) * 16384 + unit * 16 + cgp * 4;
#pragma unroll
        for (int r = 0; r < 8; ++r) { const int row = (r >> 2) * 64 + 4 * seg + (r & 3); *(f32x4*)(op + (size_t)row * 128) = (f32x4){S[r][0][0], S[r][0][1], S[r][1][0], S[r][1][1]}; }
    }
};
struct PScanC {
    static constexpr int REC = 268;
    struct Stg { h16x8 q[2], k[2], v; float beta, g; };
    const h16* base; const float* gt; int lane, seg, cgp, u8; f32x2 S[8]; float* ob;
    __device__ __forceinline__ void init(const P& p, int l, int b, int h, int unit, int lane_) {
        lane = lane_; seg = lane & 15; cgp = lane >> 4; u8 = unit * 8;
        base = (const h16*)(p.ws + WS_R1) + (size_t)b * 2048 * 1536 + h * 128; gt = (const float*)(p.ws + WS_G) + (size_t)b * 2048 * 16 + h;
        ob = (float*)(p.ws + WS_R2) + (size_t)b * 2048 * 1536 + 1024 + h * 128 + u8 + cgp * 2;
#pragma unroll
        for (int r = 0; r < 8; ++r) S[r] = (f32x2){0.f, 0.f};
    }
    __device__ __forceinline__ void issue(int blk, Stg& s) const {
        blk = blk < NPB ? blk : NPB - 1;
#pragma unroll
        for (int i = 0; i < 2; ++i) { const h16* rp = base + (size_t)(blk * PB + (lane >> 4) + 4 * i) * 1536 + (lane & 15) * 8; s.q[i] = *(const h16x8*)rp; s.k[i] = *(const h16x8*)(rp + 512); }
        if (lane < 8) { const size_t row = (size_t)(blk * PB + lane); s.v = *(const h16x8*)(base + row * 1536 + 1024 + u8); s.beta = gt[row * 16 + 8]; s.g = gt[row * 16 + 12]; }
    }
    __device__ __forceinline__ void write(const Stg& s, LAS float* slot) const {
#pragma unroll
        for (int i = 0; i < 2; ++i) { LAS float* d = slot + ((lane >> 4) + 4 * i) * REC + (lane & 15) * 8; cvt8(s.q[i], d); cvt8(s.k[i], d + 128); }
        if (lane < 8) { LAS float* d = slot + lane * REC + 256; cvt8(s.v, d); *(LAS f32x2*)(d + 8) = (f32x2){s.beta, __expf(s.g)}; }
    }
    __device__ __forceinline__ void step(const LAS float* rec, int t) {
        const f32x4 q0 = *(const LAS f32x4*)(rec + 4 * seg), q1 = *(const LAS f32x4*)(rec + 64 + 4 * seg), k0 = *(const LAS f32x4*)(rec + 128 + 4 * seg), k1 = *(const LAS f32x4*)(rec + 192 + 4 * seg);
        const f32x2 v2 = *(const LAS f32x2*)(rec + 256 + 2 * cgp), ba = *(const LAS f32x2*)(rec + 264);
        f32x2 u = {0.f, 0.f};
#pragma unroll
        for (int r = 0; r < 8; ++r) { const float kk = r < 4 ? k0[r & 3] : k1[r & 3]; u = u + S[r] * kk; }
        u[0] = red16(u[0]); u[1] = red16(u[1]);
        const float beta = ba[0], a = ba[1];
        const f32x2 vn = beta * (v2 - a * u);
        f32x2 o = {0.f, 0.f};
#pragma unroll
        for (int r = 0; r < 8; ++r) { const float kk = r < 4 ? k0[r & 3] : k1[r & 3], qq = r < 4 ? q0[r & 3] : q1[r & 3]; S[r] = a * S[r] + kk * vn; o = o + S[r] * qq; }
        o[0] = red16(o[0]); o[1] = red16(o[1]);
        if (seg == 0) *(f32x2*)(ob + (size_t)t * 1536) = o;
    }
    __device__ __forceinline__ void finish(const P& p, int l, int b, int h, int unit) const {
        float* op = p.out + O_G_P + (((size_t)l * 8 + b) * 4 + h) * 16384 + u8 + cgp * 2;
#pragma unroll
        for (int r = 0; r < 8; ++r) { const int row = (r >> 2) * 64 + 4 * seg + (r & 3); *(f32x2*)(op + (size_t)row * 128) = S[r]; }
    }
};
struct PScanB {
    static constexpr int REC = 148;
    struct Stg { h16x8 q, k, v; float ig, lf; };
    const h16* base; const float* gt; int lane, seg, vg, u16; f32x2 C[4][2], nn[2]; float m; float* ob;
    __device__ __forceinline__ void init(const P& p, int l, int b, int h, int unit, int lane_) {
        lane = lane_; seg = lane & 15; vg = lane >> 4; u16 = unit * 16;
        base = (const h16*)(p.ws + WS_P) + (size_t)b * 2048 * NPROJ; gt = (const float*)(p.ws + WS_G) + (size_t)b * 2048 * 16 + h;
        hq = h * 64; hv = h * 128 + u16;
        ob = (float*)(p.ws + WS_R2) + (size_t)b * 2048 * 1536 + 512 + h * 128 + u16 + vg * 4;
#pragma unroll
        for (int i = 0; i < 4; ++i) { C[i][0] = (f32x2){0.f, 0.f}; C[i][1] = (f32x2){0.f, 0.f}; }
        nn[0] = (f32x2){0.f, 0.f}; nn[1] = (f32x2){0.f, 0.f}; m = 0.f;
    }
    int hq, hv;
    __device__ __forceinline__ void issue(int blk, Stg& s) const {
        blk = blk < NPB ? blk : NPB - 1;
        { const h16* rp = base + (size_t)(blk * PB + (lane >> 3)) * NPROJ + hq + (lane & 7) * 8; s.q = *(const h16x8*)(rp + C_BQ); s.k = *(const h16x8*)(rp + C_BK); }
        if (lane < 16) s.v = *(const h16x8*)(base + (size_t)(blk * PB + (lane >> 1)) * NPROJ + C_BV + hv + (lane & 1) * 8);
        if (lane < 8) { const size_t row = (size_t)(blk * PB + lane); s.ig = gt[row * 16]; s.lf = gt[row * 16 + 4]; }
    }
    __device__ __forceinline__ void write(const Stg& s, LAS float* slot) const {
        { LAS float* d = slot + (lane >> 3) * REC + (lane & 7) * 8; cvt8(s.q, d); cvt8(s.k, d + 64); }
        if (lane < 16) cvt8(s.v, slot + (lane >> 1) * REC + 128 + (lane & 1) * 8);
        if (lane < 8) *(LAS f32x2*)(slot + lane * REC + 144) = (f32x2){s.ig, s.lf};
    }
    __device__ __forceinline__ void step(const LAS float* rec, int t) {
        const f32x4 q4 = *(const LAS f32x4*)(rec + 4 * seg), k4 = *(const LAS f32x4*)(rec + 64 + 4 * seg), v4 = *(const LAS f32x4*)(rec + 128 + 4 * vg);
        const f32x2 gl = *(const LAS f32x2*)(rec + 144);
        const float ig = gl[0], lf = gl[1];
        const float mn = fmaxf(lf + m, ig), wo = __expf(lf + m - mn), wi = __expf(ig - mn); m = mn;
        const f32x2 ka = {k4[0], k4[1]}, kb = {k4[2], k4[3]}, qa = {q4[0], q4[1]}, qb = {q4[2], q4[3]};
        nn[0] = wo * nn[0] + wi * ka; nn[1] = wo * nn[1] + wi * kb;
        const f32x2 dd = nn[0] * qa + nn[1] * qb; float den = red16(dd[0] + dd[1]);
        f32x4 num;
#pragma unroll
        for (int i = 0; i < 4; ++i) { const float wv = wi * v4[i]; C[i][0] = wo * C[i][0] + wv * ka; C[i][1] = wo * C[i][1] + wv * kb; const f32x2 nd = C[i][0] * qa + C[i][1] * qb; num[i] = red16(nd[0] + nd[1]); }
        const float inv = 1.0f / fmaxf(fabsf(den), __expf(-m));
        if (seg == 0) *(f32x4*)(ob + (size_t)t * 1536) = num * inv;
    }
    __device__ __forceinline__ void finish(const P& p, int l, int b, int h, int unit) const {
        const size_t bh = ((size_t)l * 8 + b) * 4 + h;
        float* op = p.out + O_MC_P + bh * 8192 + (size_t)(u16 + vg * 4) * 64 + 4 * seg;
#pragma unroll
        for (int i = 0; i < 4; ++i) *(f32x4*)(op + i * 64) = (f32x4){C[i][0][0], C[i][0][1], C[i][1][0], C[i][1][1]};
        if (unit == 0 && vg == 0) { *(f32x4*)(p.out + O_MN_P + bh * 64 + 4 * seg) = (f32x4){nn[0][0], nn[0][1], nn[1][0], nn[1][1]}; if (seg == 0) p.out[O_MM_P + bh] = m; }
    }
};
template <class Sc> __device__ __forceinline__ void run_pscan(const P& p, int l, int b, int h, int unit, int lane, LAS float* wl) {
    Sc sc; sc.init(p, l, b, h, unit, lane);
    LAS float* slot0 = wl; LAS float* slot1 = wl + 4096;
    typename Sc::Stg s0, s1;
    sc.issue(0, s0); sc.issue(1, s1);
    sc.write(s0, slot0); sc.issue(2, s0);
#pragma unroll 1
    for (int i = 0; i < NPB; i += 2) {
        sc.write(s1, slot1); sc.issue(i + 3, s1);
#pragma unroll 2
        for (int tk = 0; tk < PB; ++tk) sc.step(slot0 + tk * Sc::REC, i * PB + tk);
        sc.write(s0, slot0); sc.issue(i + 4, s0);
#pragma unroll 2
        for (int tk = 0; tk < PB; ++tk) sc.step(slot1 + tk * Sc::REC, (i + 1) * PB + tk);
    }
    sc.finish(p, l, b, h, unit);
}

__device__ void phase_scan(const P& p, int l, LAS unsigned char* lds) {
    const int lane = my_tid() & 63, wv = my_tid() >> 6; const int G = my_grid();
    if (wv < 4) {
        LAS float* wl = (LAS float*)(lds + wv * 32768);
        for (int blk = my_bid(); blk < 256; blk += G) {
            const int bh = blk >> 3, sub = blk & 7, b = bh >> 2, h = bh & 3;
            if (wv == 0) run_pscan<PScanA>(p, l, b, h, sub, lane, wl);
            else if (wv == 1) run_pscan<PScanB>(p, l, b, h, sub, lane, wl);
            else run_pscan<PScanC>(p, l, b, h, sub * 2 + (wv - 2), lane, wl);
        }
    } else {
        for (int su = my_bid() + G * (wv - 4); su < 6144; su += 4 * G) {
            const int br = su / 2048, idx = su % 2048, bh = idx >> 2, unit = idx & 3;
            if (br == 0) scanA<8>(p, l, 1, bh >> 2, bh & 3, unit, lane);
            else if (br == 1) scanB<8>(p, l, 1, bh >> 2, bh & 3, unit, lane);
            else scanC<8>(p, l, 1, bh >> 2, bh & 3, unit, lane);
        }
    }
}

__device__ void phase_norm(const P& p, int l) {
    const int lane = my_tid() & 63, wv = my_tid() >> 6, seg = lane & 15, hg = lane >> 4;
    const h16* proj = (const h16*)(p.ws + WS_P); const float* ob = (const float*)(p.ws + WS_R2); h16* ys = (h16*)(p.ws + WS_R1);
    for (int r = my_bid() + my_grid() * wv; r < T; r += my_grid() * NWAVES) {
#pragma unroll
        for (int it = 0; it < 3; ++it) {
            const int c = hg * 128 + seg * 8;
            const float* op = ob + (size_t)r * 1536 + it * 512 + c; const f32x4 o0 = *(const f32x4*)op, o1 = *(const f32x4*)(op + 4);
            float ss = 0.f;
#pragma unroll
            for (int j = 0; j < 4; ++j) ss += o0[j] * o0[j] + o1[j] * o1[j];
            ss = red16(ss); const float rs = rsqrtf(ss * (1.0f / 128.0f) + 1e-6f);
            const h16x8 gt = *(const h16x8*)(proj + (size_t)r * NPROJ + (it == 0 ? C_AG : (it == 1 ? C_BO : C_CG)) + c);
            const float* gp = p.in[it == 0 ? I_ANG : (it == 1 ? I_BNG : I_CNG)] + l * 512 + c; const f32x4 g0 = *(const f32x4*)gp, g1 = *(const f32x4*)(gp + 4);
            h16x8 y;
#pragma unroll
            for (int j = 0; j < 4; ++j) { y[j] = (h16)(o0[j] * rs * g0[j] * (float)gt[j]); y[4 + j] = (h16)(o1[j] * rs * g1[j] * (float)gt[4 + j]); }
            *(h16x8*)(ys + ((size_t)it * T + r) * 512 + c) = y;
        }
    }
}

__device__ void phase_ln(const P& p, const float* g, const float* bta, float* dst32) {
    const int lane = my_tid() & 63, wv = my_tid() >> 6;
    const float* pre = (const float*)(p.ws + WS_R2); h16* hh = (h16*)(p.ws + WS_R1);
    for (int r = my_bid() + my_grid() * wv; r < T; r += my_grid() * NWAVES) {
        f32x4 x[4]; float s = 0.f;
#pragma unroll
        for (int i = 0; i < 4; ++i) { x[i] = *(const f32x4*)(pre + (size_t)r * DM + 256 * i + 4 * lane); s += (x[i][0] + x[i][1]) + (x[i][2] + x[i][3]); }
        const float mu = red64(s) * (1.0f / DM); float q = 0.f;
#pragma unroll
        for (int i = 0; i < 4; ++i) { x[i] -= mu; q += (x[i][0] * x[i][0] + x[i][1] * x[i][1]) + (x[i][2] * x[i][2] + x[i][3] * x[i][3]); }
        const float rstd = rsqrtf(red64(q) * (1.0f / DM) + 1e-5f);
#pragma unroll
        for (int i = 0; i < 4; ++i) { const int c = 256 * i + 4 * lane; const f32x4 y = x[i] * rstd * *(const f32x4*)(g + c) + *(const f32x4*)(bta + c);
            *(f32x4*)(dst32 + (size_t)r * DM + c) = y; h16x4 o; o[0] = (h16)y[0]; o[1] = (h16)y[1]; o[2] = (h16)y[2]; o[3] = (h16)y[3]; *(h16x4*)(hh + (size_t)r * DM + c) = o; }
    }
}

#define PHASE_FN __device__ __forceinline__
PHASE_FN void ph_gemm_in(const P& p, int l, LAS unsigned char* lds) {
    unsigned char* ws = p.ws;
    pg8::Gemm g{(const h16*)(ws + WS_R1), (const h16*)(ws + WS_WIN) + (size_t)l * NPROJ * DM, T, NPROJ, DM}; pg8::StaticOrder S; S.init(T, NPROJ, my_grid(), my_bid());
    EpiIn E{(h16*)(ws + WS_P), (float*)(ws + WS_G), (const float*)(ws + WS_LB) + l * 512, p.in[I_BMI] + l * 4, p.in[I_BMF] + l * 4, p.in[I_ALOG] + l * 4, p.in[I_DTB] + l * 4};
    pg8::gemm_phase(lds, g, S, E);
}
PHASE_FN void ph_gemm_br(const P& p, int l, LAS unsigned char* lds) {
    unsigned char* ws = p.ws;
    pg8::Gemm g{(const h16*)(ws + WS_R1), (const h16*)(ws + WS_WBR) + (size_t)l * 3072 * 512, 3 * T, 3072, 512}; pg8::BranchOrder S{(int)my_grid(), (int)my_bid()};
    EpiBranch E{(const h16*)(ws + WS_P), (float*)(ws + WS_R2), (h16*)(ws + WS_R2 + (size_t)T * DM * 4)};
    pg8::gemm_phase(lds, g, S, E);
}
PHASE_FN void ph_gemm_out(const P& p, int l, LAS unsigned char* lds) {
    unsigned char* ws = p.ws;
    pg8::Gemm g{(const h16*)(ws + WS_R2 + (size_t)T * DM * 4), (const h16*)(ws + WS_WOUT) + (size_t)l * DM * DM, T, DM, DM}; pg8::StaticOrder S; S.init(T, DM, my_grid(), my_bid());
    EpiRes E{(const float*)(ws + WS_H32), (float*)(ws + WS_R2)};
    pg8::gemm_phase(lds, g, S, E);
}
PHASE_FN void ph_gemm_f1(const P& p, int l, LAS unsigned char* lds) {
    unsigned char* ws = p.ws;
    pg8::Gemm g{(const h16*)(ws + WS_R1), (const h16*)(ws + WS_WF1) + (size_t)l * 2 * FFH * DM, T, 2 * FFH, DM}; pg8::StaticOrder S; S.init(T, 2 * FFH, my_grid(), my_bid());
    EpiSwiglu E{(h16*)(ws + WS_P)};
    pg8::gemm_phase(lds, g, S, E);
}
PHASE_FN void ph_gemm_f2(const P& p, int l, LAS unsigned char* lds) {
    unsigned char* ws = p.ws;
    pg8::Gemm g{(const h16*)(ws + WS_P), (const h16*)(ws + WS_WF2) + (size_t)l * DM * FFH, T, DM, FFH}; pg8::StaticOrder S; S.init(T, DM, my_grid(), my_bid());
    EpiRes E{(const float*)(ws + WS_H32), (float*)(ws + WS_R2)};
    pg8::gemm_phase(lds, g, S, E);
}
PHASE_FN void ph_prep(const P& p, LAS unsigned char* lds) { phase_prep(p, lds); }
PHASE_FN void ph_conv(const P& p, int l) { phase_conv(p, l); }
PHASE_FN void ph_scan(const P& p, int l, LAS unsigned char* lds) { phase_scan(p, l, lds); }
PHASE_FN void ph_norm(const P& p, int l) { phase_norm(p, l); }
PHASE_FN void ph_ln(const P& p, int l, int which) {
    float* h32 = (float*)(p.ws + WS_H32);
    if (which == 0) phase_ln(p, p.in[I_L1G] + l * DM, p.in[I_L1B] + l * DM, h32);
    else phase_ln(p, p.in[I_L2G] + l * DM, p.in[I_L2B] + l * DM, l == DEPTH - 1 ? p.out + O_Y : h32);
}

template <int MASK> __global__ void __launch_bounds__(NTHREADS, 2) fwd_kernel(P p) {
    extern __shared__ __attribute__((aligned(16))) unsigned char lds_raw[];
    LAS unsigned char* lds = (LAS unsigned char*)lds_raw;
    for (int ph2 = 2 * p.lo; ph2 < 2 * p.hi; ++ph2) {
        const int ph = ph2 >> 1;
        if (ph2 & 1) { const int kb = ph == 0 ? 0 : 1 + (ph - 1) % 10; if (!((DUP_MASK >> kb) & 1)) { if (ph + 1 < p.hi) cg::this_grid().sync(); continue; } cg::this_grid().sync(); }
        if (ph == 0) { if constexpr ((MASK & 1) != 0) ph_prep(p, lds); }
        else {
            const int l = (ph - 1) / 10, k = (ph - 1) % 10;
            switch (k) {
            case 0: if constexpr ((MASK & 2) != 0) ph_gemm_in(p, l, lds); break;
            case 1: if constexpr ((MASK & 4) != 0) ph_conv(p, l); break;
            case 2: if constexpr ((MASK & 8) != 0) ph_scan(p, l, lds); break;
            case 3: if constexpr ((MASK & 16) != 0) ph_norm(p, l); break;
            case 4: if constexpr ((MASK & 32) != 0) ph_gemm_br(p, l, lds); break;
            case 5: if constexpr ((MASK & 64) != 0) ph_gemm_out(p, l, lds); break;
            case 6: if constexpr ((MASK & 128) != 0) ph_ln(p, l, 0); break;
            case 7: if constexpr ((MASK & 256) != 0) ph_gemm_f1(p, l, lds); break;
            case 8: if constexpr ((MASK & 512) != 0) ph_gemm_f2(p, l, lds); break;
            default: if constexpr ((MASK & 1024) != 0) ph_ln(p, l, 1); break;
            }
        }
        if ((ph2 & 1) && ph + 1 < p.hi) cg::this_grid().sync();
    }
}

constexpr int N_PHASES = 1 + 10 * DEPTH;
constexpr int LDS_BYTES = pg8::STAGE_BYTES;
constexpr int MASK_ALL = 2047;

template <int MASK> static bool setup_k() { return hipFuncSetAttribute((const void*)fwd_kernel<MASK>, hipFuncAttributeMaxDynamicSharedMemorySize, LDS_BYTES) == hipSuccess; }
template <int MASK> static void launch_k(int grid, hipStream_t stream, const P& p) { hipLaunchKernelGGL(fwd_kernel<MASK>, dim3(grid), dim3(NTHREADS), LDS_BYTES, stream, p); }

extern "C" void kernel_launch(void* const* d_in, const int* in_sizes, int n_in, void* d_out, int out_size, void* d_ws, size_t ws_size, hipStream_t stream) {
    static int grid = 0;
    if (grid == 0) {
        if (n_in != 26 || (size_t)out_size != O_END || ws_size < WS_END) { fprintf(stderr, "kernel_launch: unexpected sizes n_in %d out %d ws %zu (need %zu)\n", n_in, out_size, ws_size, (size_t)WS_END); grid = -1; return; }
        int dev = 0, cus = 0, per_cu = 0;
        (void)hipGetDevice(&dev); (void)hipDeviceGetAttribute(&cus, hipDeviceAttributeMultiprocessorCount, dev);
#if N_LAUNCH_MODE == 1
        bool ok = setup_k<MASK_ALL>();
        if (ok && (hipOccupancyMaxActiveBlocksPerMultiprocessor(&per_cu, (const void*)fwd_kernel<MASK_ALL>, NTHREADS, LDS_BYTES) != hipSuccess || per_cu < 1)) { fprintf(stderr, "occupancy query: %d\n", per_cu); }
#else
        bool ok = setup_k<1>() && setup_k<2>() && setup_k<4>() && setup_k<8>() && setup_k<16>() && setup_k<32>() && setup_k<64>() && setup_k<128>() && setup_k<256>() && setup_k<512>() && setup_k<1024>();
#endif
        if (!ok) { fprintf(stderr, "hipFuncSetAttribute failed\n"); grid = -1; return; }
        (void)hipGetLastError();
        grid = cus;
    }
    if (grid < 0) return;
    P p{};
    for (int i = 0; i < 26; ++i) p.in[i] = (const float*)d_in[i];
    p.out = (float*)d_out; p.ws = (unsigned char*)d_ws;
#if N_LAUNCH_MODE == 1
    p.lo = 0; p.hi = N_PHASES;
    void* args[] = {&p};
    hipError_t e = hipLaunchCooperativeKernel((const void*)fwd_kernel<MASK_ALL>, dim3(grid), dim3(NTHREADS), args, LDS_BYTES, stream);
    if (e != hipSuccess) fprintf(stderr, "cooperative launch failed: %s (grid %d)\n", hipGetErrorString(e), grid);
#else
    for (int ph = 0; ph < N_PHASES; ++ph) {
        p.lo = ph; p.hi = ph + 1;
        const int k = ph == 0 ? 0 : 1 + (ph - 1) % 10;
        switch (k) {
        case 0: launch_k<1>(grid, stream, p); break;
        case 1: launch_k<2>(grid, stream, p); break;
        case 2: launch_k<4>(grid, stream, p); break;
        case 3: launch_k<8>(grid, stream, p); break;
        case 4: launch_k<16>(grid, stream, p); break;
        case 5: launch_k<32>(grid, stream, p); break;
        case 6: launch_k<64>(grid, stream, p); break;
        case 7: launch_k<128>(grid, stream, p); break;
        case 8: launch_k<256>(grid, stream, p); break;
        case 9: launch_k<512>(grid, stream, p); break;
        default: launch_k<1024>(grid, stream, p); break;
        }
    }
#endif
}
```

```cpp
#include <hip/hip_runtime.h>
#include <hip/hip_cooperative_groups.h>
#include <cstdio>
namespace cg = cooperative_groups;

#ifndef N_LAUNCH_MODE
#define N_LAUNCH_MODE 1
#endif

#ifndef DUP_MASK
#define DUP_MASK 0
#endif
#ifndef EXTRA_SYNCS
#define EXTRA_SYNCS 0
#endif
#define LAS __attribute__((address_space(3)))
typedef _Float16 h16;
typedef _Float16 h16x8 __attribute__((ext_vector_type(8)));
typedef _Float16 h16x4 __attribute__((ext_vector_type(4)));
typedef _Float16 h16x2 __attribute__((ext_vector_type(2)));
typedef float f32x4 __attribute__((ext_vector_type(4)));
typedef float f32x2 __attribute__((ext_vector_type(2)));

constexpr int DM = 1024, TP = 16384, TS = 1024, T = TP + TS, DEPTH = 4;
constexpr int NSRC_IN = 8720, NPROJ = 8960, FFH = 2816;
constexpr int NTHREADS = 512, NWAVES = 8;
constexpr float ALPHA = 1.681792830507429f;
constexpr int C_AQ = 0, C_AF = 512, C_AI = 1024, C_AG = 1536, C_BQ = 2048, C_BK = 2304, C_BV = 2560, C_BO = 3072, C_CX = 3584, C_CG = 5120, C_MG = 5632, C_SM = 8704;

constexpr size_t SZ_WIN = (size_t)DEPTH * NPROJ * DM * 2, SZ_WBR = (size_t)DEPTH * 3072 * 512 * 2, SZ_WOUT = (size_t)DEPTH * DM * DM * 2,
                 SZ_WF1 = (size_t)DEPTH * 2 * FFH * DM * 2, SZ_WF2 = (size_t)DEPTH * DM * FFH * 2, SZ_LB = DEPTH * 512 * 4;
constexpr size_t WS_WIN = 0, WS_WBR = WS_WIN + SZ_WIN, WS_WOUT = WS_WBR + SZ_WBR, WS_WF1 = WS_WOUT + SZ_WOUT, WS_WF2 = WS_WF1 + SZ_WF1, WS_LB = WS_WF2 + SZ_WF2;
constexpr size_t WS_H32 = WS_LB + SZ_LB, WS_P = WS_H32 + (size_t)T * DM * 4, WS_G = WS_P + (size_t)T * NPROJ * 2, WS_R1 = WS_G + (size_t)T * 16 * 4,
                 WS_R2 = WS_R1 + (size_t)T * 1536 * 2, WS_BAR = WS_R2 + (size_t)T * 1536 * 4, WS_END = WS_BAR + 16384;
constexpr size_t O_Y = 0, O_HA_P = (size_t)T * DM, O_HA_S = O_HA_P + (size_t)DEPTH * 8 * 4 * 16384, O_MC_P = O_HA_S + (size_t)DEPTH * 128 * 4 * 16384,
                 O_MC_S = O_MC_P + (size_t)DEPTH * 8 * 4 * 8192, O_MN_P = O_MC_S + (size_t)DEPTH * 128 * 4 * 8192, O_MN_S = O_MN_P + DEPTH * 8 * 4 * 64,
                 O_MM_P = O_MN_S + DEPTH * 128 * 4 * 64, O_MM_S = O_MM_P + DEPTH * 8 * 4, O_G_P = O_MM_S + DEPTH * 128 * 4, O_G_S = O_G_P + (size_t)DEPTH * 8 * 4 * 16384,
                 O_CV_P = O_G_S + (size_t)DEPTH * 128 * 4 * 16384, O_CV_S = O_CV_P + (size_t)DEPTH * 8 * 3 * 1536, O_END = O_CV_S + (size_t)DEPTH * 128 * 3 * 1536;

struct P { const float* in[26]; float* out; unsigned char* ws; int lo, hi; };
enum { I_XP = 0, I_XS, I_SA, I_SC, I_SN, I_SM, I_SG, I_SV, I_WIN, I_LB, I_ANG, I_BMI, I_BMF, I_BNG, I_CW, I_ALOG, I_DTB, I_CNG, I_WBR, I_WOUT, I_L1G, I_L1B, I_WF1, I_WF2, I_L2G, I_L2B };

__device__ __forceinline__ int my_tid() { int t = threadIdx.x; asm volatile("" : "+v"(t)); return t; }
__device__ __forceinline__ int my_bid() { int b = blockIdx.x; asm volatile("" : "+s"(b)); return b; }
__device__ __forceinline__ int my_grid() { int g = gridDim.x; asm volatile("" : "+s"(g)); return g; }
__device__ __forceinline__ float sigm(float x) { return __builtin_amdgcn_rcpf(1.0f + __expf(-x)); }
__device__ __forceinline__ float silu(float x) { return x * sigm(x); }
template <int CTRL> __device__ __forceinline__ float dppf(float x) { return __builtin_bit_cast(float, __builtin_amdgcn_mov_dpp(__builtin_bit_cast(int, x), CTRL, 0xf, 0xf, true)); }
__device__ __forceinline__ float red16(float x) { x += dppf<0xB1>(x); x += dppf<0x4E>(x); x += dppf<0x124>(x); x += dppf<0x128>(x); return x; }
__device__ __forceinline__ float red64(float x) { x = red16(x); x += __shfl_xor(x, 16); x += __shfl_xor(x, 32); return x; }

namespace pg8 {
constexpr int BM = 256, BK = 64, HALF = 128, HTB = HALF * BK * 2, STAGE_BYTES = 8 * HTB, NXCD = 8, WGM = 8;
__device__ __forceinline__ int lds_byte(int r, int c) { const int st = (r >> 4) * 2 + (c >> 5), rr = r & 15, cc = c & 31, ob = rr * 64 + cc * 2; return st * 1024 + (ob ^ (((ob >> 9) & 1) << 5)); }
__device__ __forceinline__ void stage_rc(int b, int& R, int& C) { const int st = b / 1024, sb = b % 1024, swz = sb ^ (((sb >> 9) & 1) << 5); R = (st >> 1) * 16 + swz / 64; C = (st & 1) * 32 + (swz % 64) / 2; }
__device__ __forceinline__ int perm32(int rho) { const int n = rho >> 4, i = rho & 15; return 8 * (i >> 2) + 4 * n + (i & 3); }
struct Unit { int pm, pn; };
struct Gemm { const h16* A; const h16* Bt; int M, N, K; };
struct StaticOrder {
    int nM, nN, nwg, G, c;
    __device__ void init(int M, int N, int G_, int c_) { nM = M / BM; nN = N / BM; nwg = nM * nN; G = G_; c = c_; }
    __device__ bool next(int i, Unit& u) const {
        const long L = (long)i * G + c; if (L >= nwg) return false;
        int wgid = (int)L; { const int q = nwg / NXCD, r = nwg % NXCD, xcd = wgid % NXCD, off = wgid / NXCD; wgid = (xcd < r ? xcd * (q + 1) : r * (q + 1) + (xcd - r) * q) + off; }
        const int nig = WGM * nN, gid = wgid / nig, fm = gid * WGM, gsz = (nM - fm) < WGM ? (nM - fm) : WGM;
        u.pm = fm + ((wgid % nig) % gsz); u.pn = (wgid % nig) / gsz; return true;
    }
};
struct BranchOrder {
    int G, c;
    __device__ bool next(int i, Unit& u) const {
        const int ti = i / 3, br = i - 3 * ti; const int tile = ti * G + c; if (tile >= 68 * 4) return false;
        u.pm = (tile >> 2) + 68 * br; u.pn = (tile & 3) + 4 * br; return true;
    }
};

template <class Epi, class Sched>
__device__ __forceinline__ void gemm_phase(LAS unsigned char* lds, const Gemm g, const Sched& S, const Epi& E) {
    const int tid = my_tid(), wid = __builtin_amdgcn_readfirstlane(tid >> 6), lane = tid & 63, wr = wid >> 2, wc = wid & 3, fr = lane & 15, fq = lane >> 4;
    const int K = g.K, nt = K / BK;
    unsigned voffA[2], voffB[2];
#pragma unroll
    for (int i = 0; i < 2; ++i) { int R, C; stage_rc(tid * 16 + i * 8192, R, C); const int Rb = Epi::PERM ? ((R & ~31) + perm32(R & 31)) : R;
        voffA[i] = (unsigned)(R * K + C) * 2u; voffB[i] = (unsigned)(Rb * K + C) * 2u; }
    const size_t kstep = (size_t)(BK * 2);
    const size_t hstep = (size_t)HALF * K * 2;
    const size_t tstep = 2 * hstep;
    const unsigned ldsw = (unsigned)wid * 1024u;
    const int aoff = lds_byte(wr * 64 + fr, fq * 8), boff = lds_byte(wc * 32 + fr, fq * 8);
#define PG8_SA(b, h) (((b) * 2 + (h)) * HTB)
#define PG8_SB(b, h) ((4 + (b) * 2 + (h)) * HTB)
#define PG8_STAGE(bufoff, gbase, voff) do { _Pragma("unroll") for (int _i = 0; _i < 2; ++_i) \
        __builtin_amdgcn_global_load_lds((const unsigned*)((const char*)(gbase) + (voff)[_i]), (LAS unsigned*)(lds + (bufoff) + ldsw + _i * 8192), 16, 0, 0); } while (0)
#define PG8_LDA(dst, b, h) do { _Pragma("unroll") for (int m = 0; m < 4; ++m) _Pragma("unroll") for (int k = 0; k < 2; ++k) dst[m][k] = *(const LAS h16x8*)(lds + PG8_SA(b, h) + aoff + m * 2048 + k * 1024); } while (0)
#define PG8_LDB(dst, b, h) do { _Pragma("unroll") for (int n = 0; n < 2; ++n) _Pragma("unroll") for (int k = 0; k < 2; ++k) dst[n][k] = *(const LAS h16x8*)(lds + PG8_SB(b, h) + boff + n * 2048 + k * 1024); } while (0)
#define PG8_MMA(ai, bj, At, Bt) do { __builtin_amdgcn_s_setprio(1); _Pragma("unroll") for (int m = 0; m < 4; ++m) _Pragma("unroll") for (int n = 0; n < 2; ++n) _Pragma("unroll") for (int k = 0; k < 2; ++k) \
        acc[ai][bj][m][n] = __builtin_amdgcn_mfma_f32_16x16x32_f16(Bt[n][k], At[m][k], acc[ai][bj][m][n], 0, 0, 0); __builtin_amdgcn_s_setprio(0); } while (0)
#define PG8_WAIT_V(n) asm volatile("s_waitcnt vmcnt(" #n ")" ::: "memory")
#define PG8_WAIT_L(n) asm volatile("s_waitcnt lgkmcnt(" #n ")" ::: "memory")
#define PG8_BAR __builtin_amdgcn_s_barrier()
#define PG8_SCHED __builtin_amdgcn_sched_barrier(0)
    Unit cur, nxt; int ui = 0;
    if (!S.next(0, cur)) return;
    f32x4 acc[2][2][4][2];
#pragma unroll
    for (int a = 0; a < 2; ++a)
#pragma unroll
        for (int b = 0; b < 2; ++b)
#pragma unroll
            for (int m = 0; m < 4; ++m)
#pragma unroll
                for (int n = 0; n < 2; ++n) acc[a][b][m][n] = (f32x4){0.f, 0.f, 0.f, 0.f};
    h16x8 At[4][2], B0[2][2], B1[2][2];
    const char* cA = (const char*)g.A + (size_t)cur.pm * tstep; const char* cB = (const char*)g.Bt + (size_t)cur.pn * tstep;
    PG8_STAGE(PG8_SB(0, 0), cB, voffB); PG8_STAGE(PG8_SA(0, 0), cA, voffA); PG8_STAGE(PG8_SB(0, 1), cB + hstep, voffB); PG8_STAGE(PG8_SA(0, 1), cA + hstep, voffA);
    if (wr == 1) PG8_BAR;
    PG8_WAIT_V(4); PG8_BAR;
    PG8_STAGE(PG8_SB(1, 0), cB + kstep, voffB); PG8_STAGE(PG8_SA(1, 0), cA + kstep, voffA); PG8_STAGE(PG8_SB(1, 1), cB + hstep + kstep, voffB);
    PG8_WAIT_V(6); PG8_BAR;
    for (;;) {
        const bool has_next = S.next(ui + 1, nxt);
        const char* nA = has_next ? (const char*)g.A + (size_t)nxt.pm * tstep : cA; const char* nB = has_next ? (const char*)g.Bt + (size_t)nxt.pn * tstep : cB;
        for (int t = 0; t < nt; t += 2) {
            const bool last = (t == nt - 2);
            const char* a1 = cA + (size_t)(t + 1) * kstep;
            const char* a2 = last ? nA : cA + (size_t)(t + 2) * kstep; const char* b2 = last ? nB : cB + (size_t)(t + 2) * kstep;
            const char* a3 = a2 + kstep; const char* b3 = b2 + kstep;
            PG8_LDB(B0, 0, 0); PG8_SCHED; PG8_LDA(At, 0, 0); PG8_STAGE(PG8_SA(1, 1), a1 + hstep, voffA);
            PG8_WAIT_L(8); PG8_BAR; PG8_WAIT_L(0); PG8_MMA(0, 0, At, B0); PG8_BAR; PG8_SCHED;
            PG8_LDB(B1, 0, 1); PG8_STAGE(PG8_SB(0, 0), b2, voffB);
            PG8_BAR; PG8_WAIT_L(0); PG8_MMA(0, 1, At, B1); PG8_BAR;
            PG8_LDA(At, 0, 1); PG8_STAGE(PG8_SA(0, 0), a2, voffA);
            PG8_BAR; PG8_WAIT_L(0); PG8_MMA(1, 0, At, B0); PG8_BAR; PG8_SCHED;
            PG8_STAGE(PG8_SB(0, 1), b2 + hstep, voffB);
            PG8_WAIT_V(6); PG8_BAR; PG8_MMA(1, 1, At, B1); PG8_BAR;
            PG8_LDB(B0, 1, 0); PG8_SCHED; PG8_LDA(At, 1, 0); PG8_STAGE(PG8_SA(0, 1), a2 + hstep, voffA);
            PG8_WAIT_L(8); PG8_BAR; PG8_WAIT_L(0); PG8_MMA(0, 0, At, B0); PG8_BAR; PG8_SCHED;
            PG8_LDB(B1, 1, 1); PG8_STAGE(PG8_SB(1, 0), b3, voffB);
            PG8_BAR; PG8_WAIT_L(0); PG8_MMA(0, 1, At, B1); PG8_BAR;
            PG8_LDA(At, 1, 1); PG8_STAGE(PG8_SA(1, 0), a3, voffA);
            PG8_BAR; PG8_WAIT_L(0); PG8_MMA(1, 0, At, B0); PG8_BAR; PG8_SCHED;
            PG8_STAGE(PG8_SB(1, 1), b3 + hstep, voffB);
            PG8_WAIT_V(6); PG8_BAR; PG8_MMA(1, 1, At, B1); PG8_BAR;
        }
        E(acc, cur, wr, wc, fr, fq);
        if (!has_next) break;
#pragma unroll
        for (int a = 0; a < 2; ++a)
#pragma unroll
            for (int b = 0; b < 2; ++b)
#pragma unroll
                for (int m = 0; m < 4; ++m)
#pragma unroll
                    for (int n = 0; n < 2; ++n) acc[a][b][m][n] = (f32x4){0.f, 0.f, 0.f, 0.f};
        cur = nxt; cA = nA; cB = nB; ++ui;
    }
    PG8_WAIT_V(0);
    if (wr == 0) PG8_BAR;
    PG8_BAR;
#undef PG8_SA
#undef PG8_SB
#undef PG8_STAGE
#undef PG8_LDA
#undef PG8_LDB
#undef PG8_MMA
#undef PG8_WAIT_V
#undef PG8_WAIT_L
#undef PG8_BAR
#undef PG8_SCHED
}
}
using pg8::Unit;

__device__ __forceinline__ h16x8 pack8(const f32x4 a, const f32x4 b) {
    h16x8 o; o[0] = (h16)a[0]; o[1] = (h16)a[1]; o[2] = (h16)a[2]; o[3] = (h16)a[3]; o[4] = (h16)b[0]; o[5] = (h16)b[1]; o[6] = (h16)b[2]; o[7] = (h16)b[3]; return o;
}

struct EpiIn {
    static constexpr bool PERM = true;
    h16* proj; float* gates; const float* lb; const float* b_mi; const float* b_mf; const float* a_log; const float* dt_bias;
    __device__ __forceinline__ void operator()(const f32x4 (&acc)[2][2][4][2], const Unit& u, int wr, int wc, int fr, int fq) const {
        const int pn = u.pn; const int row0 = u.pm * 256 + wr * 64 + fr;
        if (pn == 34) {
            if (wc == 0 && fq < 2) {
                f32x4 c0, c1;
                if (fq == 0) { c0 = *(const f32x4*)b_mi; c1 = *(const f32x4*)b_mf; } else { c0 = *(const f32x4*)a_log; c1 = *(const f32x4*)dt_bias; }
#pragma unroll
                for (int ai = 0; ai < 2; ++ai)
#pragma unroll
                    for (int m = 0; m < 4; ++m) {
                        const f32x4 x0 = acc[ai][0][m][0], x1 = acc[ai][0][m][1]; f32x4 y0, y1;
#pragma unroll
                        for (int j = 0; j < 4; ++j) {
                            if (fq == 0) { y0[j] = x0[j] + c0[j]; const float z = x1[j] + c1[j]; y1[j] = fminf(z, 0.f) - log1pf(__expf(-fabsf(z))); }
                            else { y0[j] = sigm(x0[j]); const float z = x1[j] + c1[j]; y1[j] = -__expf(c0[j]) * (fmaxf(z, 0.f) + log1pf(__expf(-fabsf(z)))); }
                        }
                        float* gp = gates + (size_t)(row0 + ai * 128 + m * 16) * 16 + 8 * fq;
                        *(f32x4*)gp = y0; *(f32x4*)(gp + 4) = y1;
                    }
            }
            return;
        }
        int mode = 0;
        if (pn < 2) mode = 1; else if (pn < 4) mode = 3; else if (pn < 6) mode = 0; else if (pn < 8) mode = 1; else if (pn == 8) mode = 4; else if (pn < 12) mode = 0;
        else if (pn < 14) mode = 2; else if (pn < 20) mode = 0; else if (pn < 22) mode = 1; else mode = 2;
        const int col0 = pn * 256 + wc * 32 + 8 * fq;
        f32x4 lbv[2][2];
        if (mode == 3) {
#pragma unroll
            for (int bj = 0; bj < 2; ++bj)
#pragma unroll
                for (int n = 0; n < 2; ++n) lbv[bj][n] = 1.0f - *(const f32x4*)(lb + (col0 - C_AF) + bj * 128 + 4 * n);
        }
#pragma unroll
        for (int ai = 0; ai < 2; ++ai)
#pragma unroll
            for (int m = 0; m < 4; ++m) {
                h16* rowp = proj + (size_t)(row0 + ai * 128 + m * 16) * NPROJ + col0;
#pragma unroll
                for (int bj = 0; bj < 2; ++bj) {
                    f32x4 v[2] = {acc[ai][bj][m][0], acc[ai][bj][m][1]};
                    if (mode == 1) { for (int n = 0; n < 2; ++n) for (int j = 0; j < 4; ++j) v[n][j] = silu(v[n][j]); }
                    else if (mode == 2) { for (int n = 0; n < 2; ++n) for (int j = 0; j < 4; ++j) v[n][j] = sigm(v[n][j]); }
                    else if (mode == 3) { for (int n = 0; n < 2; ++n) for (int j = 0; j < 4; ++j) v[n][j] = lbv[bj][n][j] * sigm(-v[n][j]); }
                    else if (mode == 4) { v[0] *= 0.125f; v[1] *= 0.125f; }
                    *(h16x8*)(rowp + bj * 128) = pack8(v[0], v[1]);
                }
            }
    }
};
struct EpiBranch {
    static constexpr bool PERM = true;
    const h16* proj; float* mrg32; h16* mrg16;
    __device__ __forceinline__ void operator()(const f32x4 (&acc)[2][2][4][2], const Unit& u, int wr, int wc, int fr, int fq) const {
        const int br = u.pn >> 2; const int pn = u.pn & 3, pm = u.pm - 68 * br;
        const int row0 = pm * 256 + wr * 64 + fr, col0 = pn * 256 + wc * 32 + 8 * fq;
#pragma unroll
        for (int ai = 0; ai < 2; ++ai)
#pragma unroll
            for (int m = 0; m < 4; ++m) {
                const size_t row = (size_t)(row0 + ai * 128 + m * 16);
#pragma unroll
                for (int bj = 0; bj < 2; ++bj) {
                    const h16x8 gt = *(const h16x8*)(proj + row * NPROJ + C_MG + br * 1024 + col0 + bj * 128);
                    float* mp = mrg32 + row * DM + col0 + bj * 128;
                    f32x4 v0 = acc[ai][bj][m][0], v1 = acc[ai][bj][m][1];
#pragma unroll
                    for (int j = 0; j < 4; ++j) { v0[j] *= (float)gt[j]; v1[j] *= (float)gt[4 + j]; }
                    if (br > 0) { v0 += *(const f32x4*)mp; v1 += *(const f32x4*)(mp + 4); }
                    if (br < 2) { *(f32x4*)mp = v0; *(f32x4*)(mp + 4) = v1; }
                    else *(h16x8*)(mrg16 + row * DM + col0 + bj * 128) = pack8(v0, v1);
                }
            }
    }
};
struct EpiRes {
    static constexpr bool PERM = false;
    const float* h32; float* pre32;
    __device__ __forceinline__ void operator()(const f32x4 (&acc)[2][2][4][2], const Unit& u, int wr, int wc, int fr, int fq) const {
        const int row0 = u.pm * 256 + wr * 64 + fr, col0 = u.pn * 256 + wc * 32 + 4 * fq;
#pragma unroll
        for (int ai = 0; ai < 2; ++ai)
#pragma unroll
            for (int m = 0; m < 4; ++m) {
                const size_t off = (size_t)(row0 + ai * 128 + m * 16) * DM + col0;
#pragma unroll
                for (int bj = 0; bj < 2; ++bj)
#pragma unroll
                    for (int n = 0; n < 2; ++n) { const f32x4 hv = *(const f32x4*)(h32 + off + bj * 128 + n * 16); *(f32x4*)(pre32 + off + bj * 128 + n * 16) = ALPHA * hv + acc[ai][bj][m][n]; }
            }
    }
};
struct EpiSwiglu {
    static constexpr bool PERM = true;
    h16* ff;
    __device__ __forceinline__ void operator()(const f32x4 (&acc)[2][2][4][2], const Unit& u, int wr, int wc, int fr, int fq) const {
        const int row0 = u.pm * 256 + wr * 64 + fr, col0 = u.pn * 128 + wc * 32 + 8 * fq;
#pragma unroll
        for (int ai = 0; ai < 2; ++ai)
#pragma unroll
            for (int m = 0; m < 4; ++m) {
                f32x4 v[2];
#pragma unroll
                for (int n = 0; n < 2; ++n)
#pragma unroll
                    for (int j = 0; j < 4; ++j) v[n][j] = silu(acc[ai][0][m][n][j]) * acc[ai][1][m][n][j];
                *(h16x8*)(ff + (size_t)(row0 + ai * 128 + m * 16) * FFH + col0) = pack8(v[0], v[1]);
            }
    }
};

__device__ __forceinline__ int map_in(int n) {
    if (n < 3584) return n;
    if (n < 5632) return n + 8;
    if (n < 8704) return n + 16;
    if (n < 8708) return 3584 + (n - 8704);
    if (n < 8712) return 3588 + (n - 8708);
    if (n < 8716) return 5640 + (n - 8712);
    if (n < 8720) return 5644 + (n - 8716);
    return -1;
}
__device__ __forceinline__ int map_f1(int n) { const int p = n >> 8, w = n & 255; return w < 128 ? 128 * p + w : FFH + 128 * p + (w - 128); }
__device__ __forceinline__ void tr_tile(const float* __restrict__ src, int Nsrc, h16* __restrict__ dst, int K, int n0, int k0, int mapid, LAS float* tile) {
    const int tid = my_tid(), tx = tid & 63, ty = tid >> 6;
    const int n = n0 + tx; const int sc = mapid == 0 ? n : (mapid == 1 ? map_in(n) : map_f1(n));
#pragma unroll
    for (int p = 0; p < 8; ++p) { const int k = ty + 8 * p; tile[k * 65 + tx] = sc >= 0 ? src[(size_t)(k0 + k) * Nsrc + sc] : 0.f; }
    __syncthreads();
    const int kx = (tid & 31) * 2, ny = tid >> 5;
#pragma unroll
    for (int p = 0; p < 4; ++p) { const int nn = ny + 16 * p; h16x2 o; o[0] = (h16)tile[kx * 65 + nn]; o[1] = (h16)tile[(kx + 1) * 65 + nn]; *(h16x2*)(dst + (size_t)(n0 + nn) * K + k0 + kx) = o; }
    __syncthreads();
}
__device__ void phase_prep(const P& p, LAS unsigned char* lds) {
    LAS float* tile = (LAS float*)lds;
    unsigned char* ws = p.ws;
    constexpr int T_IN = (NPROJ / 64) * (DM / 64), T_BR = 3 * (1024 / 64) * (512 / 64), T_OUT = 16 * 16, T_F1 = (2 * FFH / 64) * 16, T_F2 = 16 * (FFH / 64), T_L = T_IN + T_BR + T_OUT + T_F1 + T_F2;
    for (int id = my_bid(); id < DEPTH * T_L; id += my_grid()) {
        const int l = id / T_L; int r = id - l * T_L;
        if (r < T_IN) { const int tn = r / 16, tk = r % 16; tr_tile(p.in[I_WIN] + (size_t)l * DM * NSRC_IN, NSRC_IN, (h16*)(ws + WS_WIN) + (size_t)l * NPROJ * DM, DM, tn * 64, tk * 64, 1, tile); continue; }
        r -= T_IN;
        if (r < T_BR) { const int br = r / 128, q = r % 128, tn = q / 8, tk = q % 8; tr_tile(p.in[I_WBR] + ((size_t)l * 3 + br) * 512 * 1024, 1024, (h16*)(ws + WS_WBR) + ((size_t)l * 3 + br) * 1024 * 512, 512, tn * 64, tk * 64, 0, tile); continue; }
        r -= T_BR;
        if (r < T_OUT) { const int tn = r / 16, tk = r % 16; tr_tile(p.in[I_WOUT] + (size_t)l * DM * DM, DM, (h16*)(ws + WS_WOUT) + (size_t)l * DM * DM, DM, tn * 64, tk * 64, 0, tile); continue; }
        r -= T_OUT;
        if (r < T_F1) { const int tn = r / 16, tk = r % 16; tr_tile(p.in[I_WF1] + (size_t)l * DM * 2 * FFH, 2 * FFH, (h16*)(ws + WS_WF1) + (size_t)l * 2 * FFH * DM, DM, tn * 64, tk * 64, 2, tile); continue; }
        r -= T_F1;
        { const int tn = r / (FFH / 64), tk = r % (FFH / 64); tr_tile(p.in[I_WF2] + (size_t)l * FFH * DM, DM, (h16*)(ws + WS_WF2) + (size_t)l * DM * FFH, FFH, tn * 64, tk * 64, 0, tile); }
    }
    if (my_bid() == 0) {
        const int c = my_tid(); const float* lg = p.in[I_LB];
        const float a0 = lg[c], a1 = lg[512 + c], a2 = lg[1024 + c], a3 = lg[1536 + c]; const float mx = fmaxf(fmaxf(a0, a1), fmaxf(a2, a3));
        const float e0 = expf(a0 - mx), e1 = expf(a1 - mx), e2 = expf(a2 - mx), e3 = expf(a3 - mx), inv = 1.0f / (e0 + e1 + e2 + e3);
        float* lb = (float*)(ws + WS_LB); lb[c] = 0.f; lb[512 + c] = e1 * inv; lb[1024 + c] = (e1 + e2) * inv; lb[1536 + c] = (e1 + e2 + e3) * inv;
    }
    float* h32 = (float*)(ws + WS_H32); h16* hh = (h16*)(ws + WS_R1);
    const size_t n4 = (size_t)T * DM / 4, np4 = (size_t)TP * DM / 4;
    for (size_t i = (size_t)my_bid() * NTHREADS + my_tid(); i < n4; i += (size_t)my_grid() * NTHREADS) {
        const f32x4 v = i < np4 ? ((const f32x4*)p.in[I_XP])[i] : ((const f32x4*)p.in[I_XS])[i - np4];
        ((f32x4*)h32)[i] = v; h16x4 o; o[0] = (h16)v[0]; o[1] = (h16)v[1]; o[2] = (h16)v[2]; o[3] = (h16)v[3]; ((h16x4*)hh)[i] = o;
    }
}

__device__ void phase_conv(const P& p, int l) {
    const int lane = my_tid() & 63, wv = my_tid() >> 6, seg = lane & 15, hg = lane >> 4;
    const h16* proj = (const h16*)(p.ws + WS_P); h16* cprep = (h16*)(p.ws + WS_R1);
    const float* cw = p.in[I_CW] + (size_t)l * 4 * 1536;
    for (int r = my_bid() + my_grid() * wv; r < T; r += my_grid() * NWAVES) {
        int b, pos, L, grp; if (r < TP) { grp = 0; b = r >> 11; pos = r & 2047; L = 2048; } else { grp = 1; b = (r - TP) >> 3; pos = (r - TP) & 7; L = 8; }
#pragma unroll 1
        for (int it = 0; it < 3; ++it) {
            const int c = it * 512 + hg * 128 + seg * 8;
            float a[8];
#pragma unroll
            for (int j = 0; j < 8; ++j) a[j] = 0.f;
            h16x8 xc;
#pragma unroll
            for (int d = 0; d < 4; ++d) {
                float xv[8]; bool have = true;
                if (pos - d >= 0) { const h16x8 x = *(const h16x8*)(proj + (size_t)(r - d) * NPROJ + C_CX + c); if (d == 0) xc = x;
#pragma unroll
                    for (int j = 0; j < 8; ++j) xv[j] = (float)x[j]; }
                else if (grp) { const float* sp = p.in[I_SV] + (((size_t)l * 128 + b) * 3 + (3 + pos - d)) * 1536 + c; const f32x4 s0 = *(const f32x4*)sp, s1 = *(const f32x4*)(sp + 4);
#pragma unroll
                    for (int j = 0; j < 4; ++j) { xv[j] = s0[j]; xv[4 + j] = s1[j]; } }
                else have = false;
                if (have) { const f32x4 w0 = *(const f32x4*)(cw + (3 - d) * 1536 + c), w1 = *(const f32x4*)(cw + (3 - d) * 1536 + c + 4);
#pragma unroll
                    for (int j = 0; j < 4; ++j) { a[j] += xv[j] * w0[j]; a[4 + j] += xv[4 + j] * w1[j]; } }
            }
            float ss = 0.f;
#pragma unroll
            for (int j = 0; j < 8; ++j) { a[j] = silu(a[j]); ss += a[j] * a[j]; }
            if (it < 2) { ss = red16(ss); const float sc = rsqrtf(ss + 1e-6f) * (it == 0 ? 0.08838834764831845f : 1.0f);
#pragma unroll
                for (int j = 0; j < 8; ++j) a[j] *= sc; }
            h16x8 o;
#pragma unroll
            for (int j = 0; j < 8; ++j) o[j] = (h16)a[j];
            *(h16x8*)(cprep + (size_t)r * 1536 + c) = o;
            if (pos >= L - 3) {
                float* op = p.out + (grp ? O_CV_S + (((size_t)l * 128 + b) * 3 + (pos - (L - 3))) * 1536 : O_CV_P + (((size_t)l * 8 + b) * 3 + (pos - (L - 3))) * 1536) + c;
                f32x4 o0, o1;
#pragma unroll
                for (int j = 0; j < 4; ++j) { o0[j] = (float)xc[j]; o1[j] = (float)xc[4 + j]; }
                *(f32x4*)op = o0; *(f32x4*)(op + 4) = o1;
            }
        }
    }
}

template <int NC> __device__ __forceinline__ void ld_h(const h16* p, float (&v)[NC]) {
    if constexpr (NC == 2) { const h16x2 x = *(const h16x2*)p; v[0] = (float)x[0]; v[1] = (float)x[1]; }
    else { const h16x8 x = *(const h16x8*)p;
#pragma unroll
        for (int j = 0; j < 8; ++j) v[j] = (float)x[j]; }
}
template <int NC> __device__ __forceinline__ void st_f(float* p, const float (&v)[NC]) {
    if constexpr (NC == 2) { *(f32x2*)p = (f32x2){v[0], v[1]}; }
    else { *(f32x4*)p = (f32x4){v[0], v[1], v[2], v[3]}; *(f32x4*)(p + 4) = (f32x4){v[4], v[5], v[6], v[7]}; }
}
template <int NC> __device__ __forceinline__ void ld_f(const float* p, float (&v)[NC]) {
    if constexpr (NC == 2) { const f32x2 x = *(const f32x2*)p; v[0] = x[0]; v[1] = x[1]; }
    else { const f32x4 x = *(const f32x4*)p, y = *(const f32x4*)(p + 4);
#pragma unroll
        for (int j = 0; j < 4; ++j) { v[j] = x[j]; v[4 + j] = y[j]; } }
}

template <int NC> __device__ void scanA(const P& p, int l, int grp, int b, int h, int unit, int lane) {
    const int seg = lane & 15, cgp = lane >> 4; const int L = grp ? 8 : 2048; const size_t row0 = grp ? (size_t)TP + b * 8 : (size_t)b * 2048;
    const int c0 = unit * (4 * NC) + cgp * NC;
    float S[8][NC];
    const size_t sidx = (size_t)h * 16384 + (size_t)(8 * seg) * 128 + c0;
    if (grp) { const float* sp = p.in[I_SA] + ((size_t)l * 128 + b) * 65536 + sidx;
#pragma unroll
        for (int r = 0; r < 8; ++r) ld_f<NC>(sp + r * 128, S[r]); }
    else {
#pragma unroll
        for (int r = 0; r < 8; ++r)
#pragma unroll
            for (int j = 0; j < NC; ++j) S[r][j] = 0.f; }
    const h16* base = (const h16*)(p.ws + WS_P) + row0 * NPROJ + h * 128;
    float* ob = (float*)(p.ws + WS_R2) + row0 * 1536 + h * 128 + c0;
    h16x8 qn = *(const h16x8*)(base + C_AQ + 8 * seg), kn = *(const h16x8*)(base + C_AF + 8 * seg); float vn[NC]; ld_h<NC>(base + C_AI + c0, vn);
#pragma unroll 1
    for (int t = 0; t < L; ++t) {
        const h16x8 q8 = qn, k8 = kn; float v[NC];
#pragma unroll
        for (int j = 0; j < NC; ++j) v[j] = vn[j];
        if (t + 1 < L) { const h16* nb = base + (size_t)(t + 1) * NPROJ; qn = *(const h16x8*)(nb + C_AQ + 8 * seg); kn = *(const h16x8*)(nb + C_AF + 8 * seg); ld_h<NC>(nb + C_AI + c0, vn); }
        float o[NC];
#pragma unroll
        for (int j = 0; j < NC; ++j) o[j] = 0.f;
#pragma unroll
        for (int r = 0; r < 8; ++r) { const float kk = (float)k8[r], qq = (float)q8[r];
#pragma unroll
            for (int j = 0; j < NC; ++j) { S[r][j] += kk * (v[j] - S[r][j]); o[j] += S[r][j] * qq; } }
#pragma unroll
        for (int j = 0; j < NC; ++j) o[j] = red16(o[j]);
        if (seg == 0) st_f<NC>(ob + (size_t)t * 1536, o);
    }
    float* op = p.out + (grp ? O_HA_S + ((size_t)l * 128 + b) * 65536 : O_HA_P + ((size_t)l * 8 + b) * 65536) + sidx;
#pragma unroll
    for (int r = 0; r < 8; ++r) st_f<NC>(op + r * 128, S[r]);
}
template <int NC> __device__ void scanC(const P& p, int l, int grp, int b, int h, int unit, int lane) {
    const int seg = lane & 15, cgp = lane >> 4; const int L = grp ? 8 : 2048; const size_t row0 = grp ? (size_t)TP + b * 8 : (size_t)b * 2048;
    const int c0 = unit * (4 * NC) + cgp * NC;
    float S[8][NC];
    const size_t sidx = (size_t)h * 16384 + (size_t)(8 * seg) * 128 + c0;
    if (grp) { const float* sp = p.in[I_SG] + ((size_t)l * 128 + b) * 65536 + sidx;
#pragma unroll
        for (int r = 0; r < 8; ++r) ld_f<NC>(sp + r * 128, S[r]); }
    else {
#pragma unroll
        for (int r = 0; r < 8; ++r)
#pragma unroll
            for (int j = 0; j < NC; ++j) S[r][j] = 0.f; }
    const h16* base = (const h16*)(p.ws + WS_R1) + row0 * 1536 + h * 128;
    const float* gt = (const float*)(p.ws + WS_G) + row0 * 16 + h;
    float* ob = (float*)(p.ws + WS_R2) + row0 * 1536 + 1024 + h * 128 + c0;
    h16x8 qn = *(const h16x8*)(base + 8 * seg), kn = *(const h16x8*)(base + 512 + 8 * seg); float vn[NC]; ld_h<NC>(base + 1024 + c0, vn);
    float betan = gt[8], gn = gt[12];
#pragma unroll 1
    for (int t = 0; t < L; ++t) {
        const h16x8 q8 = qn, k8 = kn; float v[NC]; const float beta = betan, a = __expf(gn);
#pragma unroll
        for (int j = 0; j < NC; ++j) v[j] = vn[j];
        if (t + 1 < L) { const h16* nb = base + (size_t)(t + 1) * 1536; qn = *(const h16x8*)(nb + 8 * seg); kn = *(const h16x8*)(nb + 512 + 8 * seg); ld_h<NC>(nb + 1024 + c0, vn);
            betan = gt[(size_t)(t + 1) * 16 + 8]; gn = gt[(size_t)(t + 1) * 16 + 12]; }
        float kf[8], qf[8];
#pragma unroll
        for (int r = 0; r < 8; ++r) { kf[r] = (float)k8[r]; qf[r] = (float)q8[r]; }
        float u[NC];
#pragma unroll
        for (int j = 0; j < NC; ++j) u[j] = 0.f;
#pragma unroll
        for (int r = 0; r < 8; ++r)
#pragma unroll
            for (int j = 0; j < NC; ++j) u[j] += S[r][j] * kf[r];
        float o[NC];
#pragma unroll
        for (int j = 0; j < NC; ++j) { u[j] = red16(u[j]); u[j] = beta * (v[j] - a * u[j]); o[j] = 0.f; }
#pragma unroll
        for (int r = 0; r < 8; ++r)
#pragma unroll
            for (int j = 0; j < NC; ++j) { S[r][j] = a * S[r][j] + kf[r] * u[j]; o[j] += S[r][j] * qf[r]; }
#pragma unroll
        for (int j = 0; j < NC; ++j) o[j] = red16(o[j]);
        if (seg == 0) st_f<NC>(ob + (size_t)t * 1536, o);
    }
    float* op = p.out + (grp ? O_G_S + ((size_t)l * 128 + b) * 65536 : O_G_P + ((size_t)l * 8 + b) * 65536) + sidx;
#pragma unroll
    for (int r = 0; r < 8; ++r) st_f<NC>(op + r * 128, S[r]);
}
template <int NV> __device__ void scanB(const P& p, int l, int grp, int b, int h, int unit, int lane) {
    const int seg = lane & 15, vg = lane >> 4; const int L = grp ? 8 : 2048; const size_t row0 = grp ? (size_t)TP + b * 8 : (size_t)b * 2048;
    const int v0 = unit * (4 * NV) + vg * NV;
    float C[NV][4], nn[4], m;
    const size_t cidx = (size_t)h * 8192 + (size_t)v0 * 64 + 4 * seg;
    if (grp) { const float* sp = p.in[I_SC] + ((size_t)l * 128 + b) * 32768 + cidx;
#pragma unroll
        for (int i = 0; i < NV; ++i) { const f32x4 x = *(const f32x4*)(sp + i * 64); C[i][0] = x[0]; C[i][1] = x[1]; C[i][2] = x[2]; C[i][3] = x[3]; }
        const f32x4 x = *(const f32x4*)(p.in[I_SN] + (((size_t)l * 128 + b) * 4 + h) * 64 + 4 * seg); nn[0] = x[0]; nn[1] = x[1]; nn[2] = x[2]; nn[3] = x[3];
        m = p.in[I_SM][((size_t)l * 128 + b) * 4 + h]; }
    else {
#pragma unroll
        for (int i = 0; i < NV; ++i) { C[i][0] = 0.f; C[i][1] = 0.f; C[i][2] = 0.f; C[i][3] = 0.f; }
        nn[0] = nn[1] = nn[2] = nn[3] = 0.f; m = 0.f; }
    const h16* base = (const h16*)(p.ws + WS_P) + row0 * NPROJ;
    const float* gt = (const float*)(p.ws + WS_G) + row0 * 16 + h;
    float* ob = (float*)(p.ws + WS_R2) + row0 * 1536 + 512 + h * 128 + v0;
    h16x4 qn = *(const h16x4*)(base + C_BQ + h * 64 + 4 * seg), kn = *(const h16x4*)(base + C_BK + h * 64 + 4 * seg); float vn[NV]; ld_h<NV>(base + C_BV + h * 128 + v0, vn);
    float ign = gt[0], lfn = gt[4];
#pragma unroll 1
    for (int t = 0; t < L; ++t) {
        const h16x4 q4 = qn, k4 = kn; float v[NV]; const float ig = ign, lf = lfn;
#pragma unroll
        for (int i = 0; i < NV; ++i) v[i] = vn[i];
        if (t + 1 < L) { const h16* nb = base + (size_t)(t + 1) * NPROJ; qn = *(const h16x4*)(nb + C_BQ + h * 64 + 4 * seg); kn = *(const h16x4*)(nb + C_BK + h * 64 + 4 * seg); ld_h<NV>(nb + C_BV + h * 128 + v0, vn);
            ign = gt[(size_t)(t + 1) * 16]; lfn = gt[(size_t)(t + 1) * 16 + 4]; }
        const float mn = fmaxf(lf + m, ig), wo = __expf(lf + m - mn), wi = __expf(ig - mn); m = mn;
        float kf[4], qf[4];
#pragma unroll
        for (int r = 0; r < 4; ++r) { kf[r] = (float)k4[r]; qf[r] = (float)q4[r]; }
        float den = 0.f;
#pragma unroll
        for (int r = 0; r < 4; ++r) { nn[r] = wo * nn[r] + wi * kf[r]; den += nn[r] * qf[r]; }
        float num[NV];
#pragma unroll
        for (int i = 0; i < NV; ++i) { const float wv = wi * v[i]; num[i] = 0.f;
#pragma unroll
            for (int r = 0; r < 4; ++r) { C[i][r] = wo * C[i][r] + wv * kf[r]; num[i] += C[i][r] * qf[r]; } }
        den = red16(den);
        const float inv = 1.0f / fmaxf(fabsf(den), __expf(-m));
#pragma unroll
        for (int i = 0; i < NV; ++i) num[i] = red16(num[i]) * inv;
        if (seg == 0) st_f<NV>(ob + (size_t)t * 1536, num);
    }
    float* op = p.out + (grp ? O_MC_S + ((size_t)l * 128 + b) * 32768 : O_MC_P + ((size_t)l * 8 + b) * 32768) + cidx;
#pragma unroll
    for (int i = 0; i < NV; ++i) *(f32x4*)(op + i * 64) = (f32x4){C[i][0], C[i][1], C[i][2], C[i][3]};
    if (unit == 0 && vg == 0) {
        const size_t bh = grp ? ((size_t)l * 128 + b) * 4 + h : ((size_t)l * 8 + b) * 4 + h;
        *(f32x4*)(p.out + (grp ? O_MN_S : O_MN_P) + bh * 64 + 4 * seg) = (f32x4){nn[0], nn[1], nn[2], nn[3]};
        if (seg == 0) p.out[(grp ? O_MM_S : O_MM_P) + bh] = m;
    }
}
__device__ __forceinline__ void cvt8(const h16x8 x, LAS float* d) {
    *(LAS f32x4*)d = (f32x4){(float)x[0], (float)x[1], (float)x[2], (float)x[3]}; *(LAS f32x4*)(d + 4) = (f32x4){(float)x[4], (float)x[5], (float)x[6], (float)x[7]};
}
constexpr int PB = 8, NPB = 2048 / PB;
struct PScanA {
    static constexpr int REC = 272;
    struct Stg { h16x8 q[2], k[2], v; };
    const h16* base; int lane, seg, cgp; f32x2 S[8][2]; float* ob;
    __device__ __forceinline__ void init(const P& p, int l, int b, int h, int unit, int lane_) {
        lane = lane_; seg = lane & 15; cgp = lane >> 4;
        base = (const h16*)(p.ws + WS_P) + (size_t)b * 2048 * NPROJ + h * 128; ob = (float*)(p.ws + WS_R2) + (size_t)b * 2048 * 1536 + h * 128 + unit * 16 + cgp * 4;
        base += unit * 16;
#pragma unroll
        for (int r = 0; r < 8; ++r) { S[r][0] = (f32x2){0.f, 0.f}; S[r][1] = (f32x2){0.f, 0.f}; }
        u16 = unit * 16;
    }
    int u16;
    __device__ __forceinline__ void issue(int blk, Stg& s) const {
        blk = blk < NPB ? blk : NPB - 1;
#pragma unroll
        for (int i = 0; i < 2; ++i) { const h16* rp = base - u16 + (size_t)(blk * PB + (lane >> 4) + 4 * i) * NPROJ + (lane & 15) * 8; s.q[i] = *(const h16x8*)(rp + C_AQ); s.k[i] = *(const h16x8*)(rp + C_AF); }
        if (lane < 16) s.v = *(const h16x8*)(base + (size_t)(blk * PB + (lane >> 1)) * NPROJ + C_AI + (lane & 1) * 8);
    }
    __device__ __forceinline__ void write(const Stg& s, LAS float* slot) const {
#pragma unroll
        for (int i = 0; i < 2; ++i) { LAS float* d = slot + ((lane >> 4) + 4 * i) * REC + (lane & 15) * 8; cvt8(s.q[i], d); cvt8(s.k[i], d + 128); }
        if (lane < 16) cvt8(s.v, slot + (lane >> 1) * REC + 256 + (lane & 1) * 8);
    }
    struct In { f32x4 q0, q1, k0, k1, v4; };
    __device__ __forceinline__ void load(const LAS float* rec, In& x) const {
        x.q0 = *(const LAS f32x4*)(rec + 4 * seg); x.q1 = *(const LAS f32x4*)(rec + 64 + 4 * seg); x.k0 = *(const LAS f32x4*)(rec + 128 + 4 * seg); x.k1 = *(const LAS f32x4*)(rec + 192 + 4 * seg);
        x.v4 = *(const LAS f32x4*)(rec + 256 + 4 * cgp);
    }
    __device__ __forceinline__ void step(const In& x, int t) {
        const f32x4 q0 = x.q0, q1 = x.q1, k0 = x.k0, k1 = x.k1, v4 = x.v4;
        const f32x2 va = {v4[0], v4[1]}, vb = {v4[2], v4[3]};
        f32x2 oa = {0.f, 0.f}, obb = {0.f, 0.f};
#pragma unroll
        for (int r = 0; r < 8; ++r) { const float kk = r < 4 ? k0[r & 3] : k1[r & 3], qq = r < 4 ? q0[r & 3] : q1[r & 3];
            S[r][0] = S[r][0] + kk * (va - S[r][0]); S[r][1] = S[r][1] + kk * (vb - S[r][1]); oa = oa + S[r][0] * qq; obb = obb + S[r][1] * qq; }
        f32x4 o = {red16(oa[0]), red16(oa[1]), red16(obb[0]), red16(obb[1])};
        if (seg == 0) *(f32x4*)(ob + (size_t)t * 1536) = o;
    }
    __device__ __forceinline__ void finish(const P& p, int l, int b, int h, int unit) const {
        float* op = p.out + O_HA_P + (((size_t)l * 8 + b) * 4 + h) * 16384 + unit * 16 + cgp * 4;
#pragma unroll
        for (int r = 0; r < 8; ++r) { const int row = (r >> 2) * 64 + 4 * seg + (r & 3); *(f32x4*)(op + (size_t)row * 128) = (f32x4){S[r][0][0], S[r][0][1], S[r][1][0], S[r][1][1]}; }
    }
};
struct PScanC {
    static constexpr int REC = 268;
    struct Stg { h16x8 q[2], k[2], v; float beta, g; };
    const h16* base; const float* gt; int lane, seg, cgp, u8; f32x2 S[8]; float* ob;
    __device__ __forceinline__ void init(const P& p, int l, int b, int h, int unit, int lane_) {
        lane = lane_; seg = lane & 15; cgp = lane >> 4; u8 = unit * 8;
        base = (const h16*)(p.ws + WS_R1) + (size_t)b * 2048 * 1536 + h * 128; gt = (const float*)(p.ws + WS_G) + (size_t)b * 2048 * 16 + h;
        ob = (float*)(p.ws + WS_R2) + (size_t)b * 2048 * 1536 + 1024 + h * 128 + u8 + cgp * 2;
#pragma unroll
        for (int r = 0; r < 8; ++r) S[r] = (f32x2){0.f, 0.f};
    }
    __device__ __forceinline__ void issue(int blk, Stg& s) const {
        blk = blk < NPB ? blk : NPB - 1;
#pragma unroll
        for (int i = 0; i < 2; ++i) { const h16* rp = base + (size_t)(blk * PB + (lane >> 4) + 4 * i) * 1536 + (lane & 15) * 8; s.q[i] = *(const h16x8*)rp; s.k[i] = *(const h16x8*)(rp + 512); }
        if (lane < 8) { const size_t row = (size_t)(blk * PB + lane); s.v = *(const h16x8*)(base + row * 1536 + 1024 + u8); s.beta = gt[row * 16 + 8]; s.g = gt[row * 16 + 12]; }
    }
    __device__ __forceinline__ void write(const Stg& s, LAS float* slot) const {
#pragma unroll
        for (int i = 0; i < 2; ++i) { LAS float* d = slot + ((lane >> 4) + 4 * i) * REC + (lane & 15) * 8; cvt8(s.q[i], d); cvt8(s.k[i], d + 128); }
        if (lane < 8) { LAS float* d = slot + lane * REC + 256; cvt8(s.v, d); *(LAS f32x2*)(d + 8) = (f32x2){s.beta, __expf(s.g)}; }
    }
    struct In { f32x4 q0, q1, k0, k1; f32x2 v2, ba; };
    __device__ __forceinline__ void load(const LAS float* rec, In& x) const {
        x.q0 = *(const LAS f32x4*)(rec + 4 * seg); x.q1 = *(const LAS f32x4*)(rec + 64 + 4 * seg); x.k0 = *(const LAS f32x4*)(rec + 128 + 4 * seg); x.k1 = *(const LAS f32x4*)(rec + 192 + 4 * seg);
        x.v2 = *(const LAS f32x2*)(rec + 256 + 2 * cgp); x.ba = *(const LAS f32x2*)(rec + 264);
    }
    __device__ __forceinline__ void step(const In& x, int t) {
        const f32x4 q0 = x.q0, q1 = x.q1, k0 = x.k0, k1 = x.k1; const f32x2 v2 = x.v2, ba = x.ba;
        f32x2 u = {0.f, 0.f};
#pragma unroll
        for (int r = 0; r < 8; ++r) { const float kk = r < 4 ? k0[r & 3] : k1[r & 3]; u = u + S[r] * kk; }
        u[0] = red16(u[0]); u[1] = red16(u[1]);
        const float beta = ba[0], a = ba[1];
        const f32x2 vn = beta * (v2 - a * u);
        f32x2 o = {0.f, 0.f};
#pragma unroll
        for (int r = 0; r < 8; ++r) { const float kk = r < 4 ? k0[r & 3] : k1[r & 3], qq = r < 4 ? q0[r & 3] : q1[r & 3]; S[r] = a * S[r] + kk * vn; o = o + S[r] * qq; }
        o[0] = red16(o[0]); o[1] = red16(o[1]);
        if (seg == 0) *(f32x2*)(ob + (size_t)t * 1536) = o;
    }
    __device__ __forceinline__ void finish(const P& p, int l, int b, int h, int unit) const {
        float* op = p.out + O_G_P + (((size_t)l * 8 + b) * 4 + h) * 16384 + u8 + cgp * 2;
#pragma unroll
        for (int r = 0; r < 8; ++r) { const int row = (r >> 2) * 64 + 4 * seg + (r & 3); *(f32x2*)(op + (size_t)row * 128) = S[r]; }
    }
};
struct PScanB {
    static constexpr int REC = 148;
    struct Stg { h16x8 q, k, v; float ig, lf; };
    const h16* base; const float* gt; int lane, seg, vg, u16; f32x2 C[4][2], nn[2]; float m; float* ob;
    __device__ __forceinline__ void init(const P& p, int l, int b, int h, int unit, int lane_) {
        lane = lane_; seg = lane & 15; vg = lane >> 4; u16 = unit * 16;
        base = (const h16*)(p.ws + WS_P) + (size_t)b * 2048 * NPROJ; gt = (const float*)(p.ws + WS_G) + (size_t)b * 2048 * 16 + h;
        hq = h * 64; hv = h * 128 + u16;
        ob = (float*)(p.ws + WS_R2) + (size_t)b * 2048 * 1536 + 512 + h * 128 + u16 + vg * 4;
#pragma unroll
        for (int i = 0; i < 4; ++i) { C[i][0] = (f32x2){0.f, 0.f}; C[i][1] = (f32x2){0.f, 0.f}; }
        nn[0] = (f32x2){0.f, 0.f}; nn[1] = (f32x2){0.f, 0.f}; m = 0.f;
    }
    int hq, hv;
    __device__ __forceinline__ void issue(int blk, Stg& s) const {
        blk = blk < NPB ? blk : NPB - 1;
        { const h16* rp = base + (size_t)(blk * PB + (lane >> 3)) * NPROJ + hq + (lane & 7) * 8; s.q = *(const h16x8*)(rp + C_BQ); s.k = *(const h16x8*)(rp + C_BK); }
        if (lane < 16) s.v = *(const h16x8*)(base + (size_t)(blk * PB + (lane >> 1)) * NPROJ + C_BV + hv + (lane & 1) * 8);
        if (lane < 8) { const size_t row = (size_t)(blk * PB + lane); s.ig = gt[row * 16]; s.lf = gt[row * 16 + 4]; }
    }
    __device__ __forceinline__ void write(const Stg& s, LAS float* slot) const {
        { LAS float* d = slot + (lane >> 3) * REC + (lane & 7) * 8; cvt8(s.q, d); cvt8(s.k, d + 64); }
        if (lane < 16) cvt8(s.v, slot + (lane >> 1) * REC + 128 + (lane & 1) * 8);
        if (lane < 8) *(LAS f32x2*)(slot + lane * REC + 144) = (f32x2){s.ig, s.lf};
    }
    struct In { f32x4 q4, k4, v4; f32x2 gl; };
    __device__ __forceinline__ void load(const LAS float* rec, In& x) const {
        x.q4 = *(const LAS f32x4*)(rec + 4 * seg); x.k4 = *(const LAS f32x4*)(rec + 64 + 4 * seg); x.v4 = *(const LAS f32x4*)(rec + 128 + 4 * vg); x.gl = *(const LAS f32x2*)(rec + 144);
    }
    __device__ __forceinline__ void step(const In& x, int t) {
        const f32x4 q4 = x.q4, k4 = x.k4, v4 = x.v4; const f32x2 gl = x.gl;
        const float ig = gl[0], lf = gl[1];
        const float mn = fmaxf(lf + m, ig), wo = __expf(lf + m - mn), wi = __expf(ig - mn); m = mn;
        const f32x2 ka = {k4[0], k4[1]}, kb = {k4[2], k4[3]}, qa = {q4[0], q4[1]}, qb = {q4[2], q4[3]};
        nn[0] = wo * nn[0] + wi * ka; nn[1] = wo * nn[1] + wi * kb;
        const f32x2 dd = nn[0] * qa + nn[1] * qb; float den = red16(dd[0] + dd[1]);
        f32x4 num;
#pragma unroll
        for (int i = 0; i < 4; ++i) { const float wv = wi * v4[i]; C[i][0] = wo * C[i][0] + wv * ka; C[i][1] = wo * C[i][1] + wv * kb; const f32x2 nd = C[i][0] * qa + C[i][1] * qb; num[i] = red16(nd[0] + nd[1]); }
        const float inv = 1.0f / fmaxf(fabsf(den), __expf(-m));
        if (seg == 0) *(f32x4*)(ob + (size_t)t * 1536) = num * inv;
    }
    __device__ __forceinline__ void finish(const P& p, int l, int b, int h, int unit) const {
        const size_t bh = ((size_t)l * 8 + b) * 4 + h;
        float* op = p.out + O_MC_P + bh * 8192 + (size_t)(u16 + vg * 4) * 64 + 4 * seg;
#pragma unroll
        for (int i = 0; i < 4; ++i) *(f32x4*)(op + i * 64) = (f32x4){C[i][0][0], C[i][0][1], C[i][1][0], C[i][1][1]};
        if (unit == 0 && vg == 0) { *(f32x4*)(p.out + O_MN_P + bh * 64 + 4 * seg) = (f32x4){nn[0][0], nn[0][1], nn[1][0], nn[1][1]}; if (seg == 0) p.out[O_MM_P + bh] = m; }
    }
};
template <class Sc> __device__ __forceinline__ void run_pscan(const P& p, int l, int b, int h, int unit, int lane, LAS float* wl) {
    Sc sc; sc.init(p, l, b, h, unit, lane);
    LAS float* slot0 = wl; LAS float* slot1 = wl + 4096;
    typename Sc::Stg s0, s1;
    sc.issue(0, s0); sc.issue(1, s1);
    sc.write(s0, slot0); sc.issue(2, s0);
    typename Sc::In cur, nxt;
    sc.load(slot0, cur);
#pragma unroll 1
    for (int i = 0; i < NPB; i += 2) {
        sc.write(s1, slot1); sc.issue(i + 3, s1);
#pragma unroll
        for (int tk = 0; tk < PB; ++tk) { sc.load(tk + 1 < PB ? slot0 + (tk + 1) * Sc::REC : slot1, nxt); sc.step(cur, i * PB + tk); cur = nxt; }
        sc.write(s0, slot0); sc.issue(i + 4, s0);
#pragma unroll
        for (int tk = 0; tk < PB; ++tk) { sc.load(tk + 1 < PB ? slot1 + (tk + 1) * Sc::REC : slot0, nxt); sc.step(cur, (i + 1) * PB + tk); cur = nxt; }
    }
    sc.finish(p, l, b, h, unit);
}

__device__ void phase_scan(const P& p, int l, LAS unsigned char* lds) {
    const int lane = my_tid() & 63, wv = my_tid() >> 6; const int G = my_grid();
    if (wv < 4) {
        LAS float* wl = (LAS float*)(lds + wv * 32768);
        for (int blk = my_bid(); blk < 256; blk += G) {
            const int bh = blk >> 3, sub = blk & 7, b = bh >> 2, h = bh & 3;
            if (wv == 0) run_pscan<PScanA>(p, l, b, h, sub, lane, wl);
            else if (wv == 1) run_pscan<PScanB>(p, l, b, h, sub, lane, wl);
            else run_pscan<PScanC>(p, l, b, h, sub * 2 + (wv - 2), lane, wl);
        }
    } else {
        for (int su = my_bid() + G * (wv - 4); su < 6144; su += 4 * G) {
            const int br = su / 2048, idx = su % 2048, bh = idx >> 2, unit = idx & 3;
            if (br == 0) scanA<8>(p, l, 1, bh >> 2, bh & 3, unit, lane);
            else if (br == 1) scanB<8>(p, l, 1, bh >> 2, bh & 3, unit, lane);
            else scanC<8>(p, l, 1, bh >> 2, bh & 3, unit, lane);
        }
    }
}

__device__ void phase_norm(const P& p, int l) {
    const int lane = my_tid() & 63, wv = my_tid() >> 6, seg = lane & 15, hg = lane >> 4;
    const h16* proj = (const h16*)(p.ws + WS_P); const float* ob = (const float*)(p.ws + WS_R2); h16* ys = (h16*)(p.ws + WS_R1);
    for (int r = my_bid() + my_grid() * wv; r < T; r += my_grid() * NWAVES) {
#pragma unroll
        for (int it = 0; it < 3; ++it) {
            const int c = hg * 128 + seg * 8;
            const float* op = ob + (size_t)r * 1536 + it * 512 + c; const f32x4 o0 = *(const f32x4*)op, o1 = *(const f32x4*)(op + 4);
            float ss = 0.f;
#pragma unroll
            for (int j = 0; j < 4; ++j) ss += o0[j] * o0[j] + o1[j] * o1[j];
            ss = red16(ss); const float rs = rsqrtf(ss * (1.0f / 128.0f) + 1e-6f);
            const h16x8 gt = *(const h16x8*)(proj + (size_t)r * NPROJ + (it == 0 ? C_AG : (it == 1 ? C_BO : C_CG)) + c);
            const float* gp = p.in[it == 0 ? I_ANG : (it == 1 ? I_BNG : I_CNG)] + l * 512 + c; const f32x4 g0 = *(const f32x4*)gp, g1 = *(const f32x4*)(gp + 4);
            h16x8 y;
#pragma unroll
            for (int j = 0; j < 4; ++j) { y[j] = (h16)(o0[j] * rs * g0[j] * (float)gt[j]); y[4 + j] = (h16)(o1[j] * rs * g1[j] * (float)gt[4 + j]); }
            *(h16x8*)(ys + ((size_t)it * T + r) * 512 + c) = y;
        }
    }
}

__device__ void phase_ln(const P& p, const float* g, const float* bta, float* dst32) {
    const int lane = my_tid() & 63, wv = my_tid() >> 6;
    const float* pre = (const float*)(p.ws + WS_R2); h16* hh = (h16*)(p.ws + WS_R1);
    for (int r = my_bid() + my_grid() * wv; r < T; r += my_grid() * NWAVES) {
        f32x4 x[4]; float s = 0.f;
#pragma unroll
        for (int i = 0; i < 4; ++i) { x[i] = *(const f32x4*)(pre + (size_t)r * DM + 256 * i + 4 * lane); s += (x[i][0] + x[i][1]) + (x[i][2] + x[i][3]); }
        const float mu = red64(s) * (1.0f / DM); float q = 0.f;
#pragma unroll
        for (int i = 0; i < 4; ++i) { x[i] -= mu; q += (x[i][0] * x[i][0] + x[i][1] * x[i][1]) + (x[i][2] * x[i][2] + x[i][3] * x[i][3]); }
        const float rstd = rsqrtf(red64(q) * (1.0f / DM) + 1e-5f);
#pragma unroll
        for (int i = 0; i < 4; ++i) { const int c = 256 * i + 4 * lane; const f32x4 y = x[i] * rstd * *(const f32x4*)(g + c) + *(const f32x4*)(bta + c);
            *(f32x4*)(dst32 + (size_t)r * DM + c) = y; h16x4 o; o[0] = (h16)y[0]; o[1] = (h16)y[1]; o[2] = (h16)y[2]; o[3] = (h16)y[3]; *(h16x4*)(hh + (size_t)r * DM + c) = o; }
    }
}

#define XB_TMO      128
#define XB_XCNT(j)  (256  + 64 * (j))
#define XB_XSUB(j)  (1280 + 64 * (j))
#define XB_XGEN(j)  (2304 + 64 * (j))
#define XB_TOP      3328
#define XB_TOPGEN   3392
#define XCD_BAR_WORDS 3456
#define XB_SPIN_CAP (1u << 20)
__device__ __forceinline__ unsigned xb_ld(unsigned* p)              { return __hip_atomic_load(p, __ATOMIC_RELAXED, __HIP_MEMORY_SCOPE_AGENT); }
__device__ __forceinline__ unsigned xb_add(unsigned* p, unsigned v) { return __hip_atomic_fetch_add(p, v, __ATOMIC_RELAXED, __HIP_MEMORY_SCOPE_AGENT); }
__device__ __forceinline__ unsigned xb_xcc_id() { return (unsigned)__builtin_amdgcn_s_getreg((3 << 11) | 20) & 0xFu; }
#define XB_SPIN(cond, bar) do { unsigned _sp = 0; while (cond) { __builtin_amdgcn_s_sleep(1); \
    if ((++_sp & 255u) == 0u) { if (xb_ld(&(bar)[XB_TMO])) break; if (_sp > XB_SPIN_CAP) { atomicAdd(&(bar)[XB_TMO], 1u); break; } } } } while (0)
struct XcdBarrier { unsigned* bar; unsigned x; volatile LAS unsigned* st; };
__device__ __forceinline__ XcdBarrier xcd_barrier_post(unsigned* bar, volatile LAS unsigned* st) {
    XcdBarrier b; b.bar = bar; b.x = xb_xcc_id(); b.st = st;
    if (threadIdx.x == 0) (void)xb_add(&bar[XB_XCNT(b.x)], 1u);
    return b;
}
__device__ __forceinline__ void xcd_barrier_complete(unsigned* bar, unsigned x, unsigned& nloc, unsigned& nx) {
    const unsigned G = gridDim.x * gridDim.y * gridDim.z;
    unsigned sum, cnt, mine, sp = 0u;
    for (;;) {
        sum = 0u; cnt = 0u; mine = 0u;
#pragma unroll
        for (unsigned j = 0; j < 16; ++j) { const unsigned c = xb_ld(&bar[XB_XCNT(j)]); sum += c; cnt += (c > 0u) ? 1u : 0u; mine = (j == x) ? c : mine; }
        if (sum == G) break;
        __builtin_amdgcn_s_sleep(1);
        if ((++sp & 255u) == 0u) { if (xb_ld(&bar[XB_TMO])) break; if (sp > XB_SPIN_CAP) { atomicAdd(&bar[XB_TMO], 1u); break; } }
    }
    nloc = mine > 0u ? mine : 1u; nx = cnt > 0u ? cnt : 1u;
}
__device__ __forceinline__ void xcd_barrier(const XcdBarrier& b) {
    asm volatile("s_waitcnt vmcnt(0)" ::: "memory");
    __syncthreads();
    if (threadIdx.x == 0) {
        unsigned* bar = b.bar;
        __builtin_amdgcn_s_waitcnt(0);
        unsigned nloc = b.st[0], nx = b.st[1];
        if (nloc == 0u) { xcd_barrier_complete(bar, b.x, nloc, nx); b.st[0] = nloc; b.st[1] = nx; }
        const unsigned old = xb_add(&bar[XB_XSUB(b.x)], 1u);
        const unsigned gen = old / nloc;
        if (old + 1u == (gen + 1u) * nloc) {
            __builtin_amdgcn_fence(__ATOMIC_RELEASE, "agent");
            asm volatile("s_waitcnt vmcnt(0)" ::: "memory");
            const unsigned og = xb_add(&bar[XB_TOP], 1u);
            const unsigned tg = og / nx;
            if (og + 1u == (tg + 1u) * nx) xb_add(&bar[XB_TOPGEN], 1u);
            else XB_SPIN(xb_ld(&bar[XB_TOPGEN]) == tg, bar);
            __builtin_amdgcn_fence(__ATOMIC_ACQUIRE, "agent");
            xb_add(&bar[XB_XGEN(b.x)], 1u);
            asm volatile("s_waitcnt vmcnt(0)" ::: "memory");
        } else {
            XB_SPIN(xb_ld(&bar[XB_XGEN(b.x)]) == gen, bar);
            __builtin_amdgcn_fence(__ATOMIC_ACQUIRE, "agent");
            asm volatile("s_waitcnt vmcnt(0)" ::: "memory");
        }
    }
    __syncthreads();
}

#define PHASE_FN __device__ __forceinline__
PHASE_FN void ph_gemm_in(const P& p, int l, LAS unsigned char* lds) {
    unsigned char* ws = p.ws;
    pg8::Gemm g{(const h16*)(ws + WS_R1), (const h16*)(ws + WS_WIN) + (size_t)l * NPROJ * DM, T, NPROJ, DM}; pg8::StaticOrder S; S.init(T, NPROJ, my_grid(), my_bid());
    EpiIn E{(h16*)(ws + WS_P), (float*)(ws + WS_G), (const float*)(ws + WS_LB) + l * 512, p.in[I_BMI] + l * 4, p.in[I_BMF] + l * 4, p.in[I_ALOG] + l * 4, p.in[I_DTB] + l * 4};
    pg8::gemm_phase(lds, g, S, E);
}
PHASE_FN void ph_gemm_br(const P& p, int l, LAS unsigned char* lds) {
    unsigned char* ws = p.ws;
    pg8::Gemm g{(const h16*)(ws + WS_R1), (const h16*)(ws + WS_WBR) + (size_t)l * 3072 * 512, 3 * T, 3072, 512}; pg8::BranchOrder S{(int)my_grid(), (int)my_bid()};
    EpiBranch E{(const h16*)(ws + WS_P), (float*)(ws + WS_R2), (h16*)(ws + WS_R2 + (size_t)T * DM * 4)};
    pg8::gemm_phase(lds, g, S, E);
}
PHASE_FN void ph_gemm_out(const P& p, int l, LAS unsigned char* lds) {
    unsigned char* ws = p.ws;
    pg8::Gemm g{(const h16*)(ws + WS_R2 + (size_t)T * DM * 4), (const h16*)(ws + WS_WOUT) + (size_t)l * DM * DM, T, DM, DM}; pg8::StaticOrder S; S.init(T, DM, my_grid(), my_bid());
    EpiRes E{(const float*)(ws + WS_H32), (float*)(ws + WS_R2)};
    pg8::gemm_phase(lds, g, S, E);
}
PHASE_FN void ph_gemm_f1(const P& p, int l, LAS unsigned char* lds) {
    unsigned char* ws = p.ws;
    pg8::Gemm g{(const h16*)(ws + WS_R1), (const h16*)(ws + WS_WF1) + (size_t)l * 2 * FFH * DM, T, 2 * FFH, DM}; pg8::StaticOrder S; S.init(T, 2 * FFH, my_grid(), my_bid());
    EpiSwiglu E{(h16*)(ws + WS_P)};
    pg8::gemm_phase(lds, g, S, E);
}
PHASE_FN void ph_gemm_f2(const P& p, int l, LAS unsigned char* lds) {
    unsigned char* ws = p.ws;
    pg8::Gemm g{(const h16*)(ws + WS_P), (const h16*)(ws + WS_WF2) + (size_t)l * DM * FFH, T, DM, FFH}; pg8::StaticOrder S; S.init(T, DM, my_grid(), my_bid());
    EpiRes E{(const float*)(ws + WS_H32), (float*)(ws + WS_R2)};
    pg8::gemm_phase(lds, g, S, E);
}
PHASE_FN void ph_prep(const P& p, LAS unsigned char* lds) { phase_prep(p, lds); }
PHASE_FN void ph_conv(const P& p, int l) { phase_conv(p, l); }
PHASE_FN void ph_scan(const P& p, int l, LAS unsigned char* lds) { phase_scan(p, l, lds); }
PHASE_FN void ph_norm(const P& p, int l) { phase_norm(p, l); }
PHASE_FN void ph_ln(const P& p, int l, int which) {
    float* h32 = (float*)(p.ws + WS_H32);
    if (which == 0) phase_ln(p, p.in[I_L1G] + l * DM, p.in[I_L1B] + l * DM, h32);
    else phase_ln(p, p.in[I_L2G] + l * DM, p.in[I_L2B] + l * DM, l == DEPTH - 1 ? p.out + O_Y : h32);
}

template <int MASK> __global__ void __launch_bounds__(NTHREADS, 2) fwd_kernel(P p) {
    extern __shared__ __attribute__((aligned(16))) unsigned char lds_raw[];
    LAS unsigned char* lds = (LAS unsigned char*)lds_raw;
    volatile LAS unsigned* bst = (volatile LAS unsigned*)(lds + pg8::STAGE_BYTES);
    if (threadIdx.x == 0) { bst[0] = 0u; bst[1] = 0u; }
    __syncthreads();
    XcdBarrier xbar; xbar.bar = (unsigned*)(p.ws + WS_BAR); xbar.x = 0; xbar.st = bst;
    if (p.hi - p.lo > 1) xbar = xcd_barrier_post((unsigned*)(p.ws + WS_BAR), bst);
#define GRID_SYNC(ph_) do { if ((ph_) == 0) cg::this_grid().sync(); else xcd_barrier(xbar); } while (0)
    for (int e = 0; e < EXTRA_SYNCS; ++e) xcd_barrier(xbar);
    for (int ph2 = 2 * p.lo; ph2 < 2 * p.hi; ++ph2) {
        const int ph = ph2 >> 1;
        if (ph2 & 1) { const int kb = ph == 0 ? 0 : 1 + (ph - 1) % 10; if (!((DUP_MASK >> kb) & 1)) { if (ph + 1 < p.hi) GRID_SYNC(ph); continue; } GRID_SYNC(ph); }
        if (ph == 0) { if constexpr ((MASK & 1) != 0) ph_prep(p, lds); }
        else {
            const int l = (ph - 1) / 10, k = (ph - 1) % 10;
            switch (k) {
            case 0: if constexpr ((MASK & 2) != 0) ph_gemm_in(p, l, lds); break;
            case 1: if constexpr ((MASK & 4) != 0) ph_conv(p, l); break;
            case 2: if constexpr ((MASK & 8) != 0) ph_scan(p, l, lds); break;
            case 3: if constexpr ((MASK & 16) != 0) ph_norm(p, l); break;
            case 4: if constexpr ((MASK & 32) != 0) ph_gemm_br(p, l, lds); break;
            case 5: if constexpr ((MASK & 64) != 0) ph_gemm_out(p, l, lds); break;
            case 6: if constexpr ((MASK & 128) != 0) ph_ln(p, l, 0); break;
            case 7: if constexpr ((MASK & 256) != 0) ph_gemm_f1(p, l, lds); break;
            case 8: if constexpr ((MASK & 512) != 0) ph_gemm_f2(p, l, lds); break;
            default: if constexpr ((MASK & 1024) != 0) ph_ln(p, l, 1); break;
            }
        }
        if ((ph2 & 1) && ph + 1 < p.hi) GRID_SYNC(ph);
    }
}

constexpr int N_PHASES = 1 + 10 * DEPTH;
constexpr int LDS_BYTES = pg8::STAGE_BYTES + 16;
constexpr int MASK_ALL = 2047;

template <int MASK> static bool setup_k() { return hipFuncSetAttribute((const void*)fwd_kernel<MASK>, hipFuncAttributeMaxDynamicSharedMemorySize, LDS_BYTES) == hipSuccess; }
template <int MASK> static void launch_k(int grid, hipStream_t stream, const P& p) { hipLaunchKernelGGL(fwd_kernel<MASK>, dim3(grid), dim3(NTHREADS), LDS_BYTES, stream, p); }

extern "C" void kernel_launch(void* const* d_in, const int* in_sizes, int n_in, void* d_out, int out_size, void* d_ws, size_t ws_size, hipStream_t stream) {
    static int grid = 0;
    if (grid == 0) {
        if (n_in != 26 || (size_t)out_size != O_END || ws_size < WS_END) { fprintf(stderr, "kernel_launch: unexpected sizes n_in %d out %d ws %zu (need %zu)\n", n_in, out_size, ws_size, (size_t)WS_END); grid = -1; return; }
        int dev = 0, cus = 0, per_cu = 0;
        (void)hipGetDevice(&dev); (void)hipDeviceGetAttribute(&cus, hipDeviceAttributeMultiprocessorCount, dev);
#if N_LAUNCH_MODE == 1
        bool ok = setup_k<MASK_ALL>();
        if (ok && (hipOccupancyMaxActiveBlocksPerMultiprocessor(&per_cu, (const void*)fwd_kernel<MASK_ALL>, NTHREADS, LDS_BYTES) != hipSuccess || per_cu < 1)) { fprintf(stderr, "occupancy query: %d\n", per_cu); }
#else
        bool ok = setup_k<1>() && setup_k<2>() && setup_k<4>() && setup_k<8>() && setup_k<16>() && setup_k<32>() && setup_k<64>() && setup_k<128>() && setup_k<256>() && setup_k<512>() && setup_k<1024>();
#endif
        if (!ok) { fprintf(stderr, "hipFuncSetAttribute failed\n"); grid = -1; return; }
        (void)hipGetLastError();
        grid = cus;
    }
    if (grid < 0) return;
    P p{};
    for (int i = 0; i < 26; ++i) p.in[i] = (const float*)d_in[i];
    p.out = (float*)d_out; p.ws = (unsigned char*)d_ws;
#if N_LAUNCH_MODE == 1
    if (hipMemsetAsync((unsigned char*)d_ws + WS_BAR, 0, XCD_BAR_WORDS * 4, stream) != hipSuccess) { fprintf(stderr, "memset of barrier words failed\n"); return; }
    p.lo = 0; p.hi = N_PHASES;
    void* args[] = {&p};
    hipError_t e = hipLaunchCooperativeKernel((const void*)fwd_kernel<MASK_ALL>, dim3(grid), dim3(NTHREADS), args, LDS_BYTES, stream);
    if (e != hipSuccess) fprintf(stderr, "cooperative launch failed: %s (grid %d)\n", hipGetErrorString(e), grid);
#else
    for (int ph = 0; ph < N_PHASES; ++ph) {
        p.lo = ph; p.hi = ph + 1;
        const int k = ph == 0 ? 0 : 1 + (ph - 1) % 10;
        switch (k) {
        case 0: launch_k<1>(grid, stream, p); break;
        case 1: launch_k<2>(grid, stream, p); break;
        case 2: launch_k<4>(grid, stream, p); break;
        case 3: launch_k<8>(grid, stream, p); break;
        case 4: launch_k<16>(grid, stream, p); break;
        case 5: launch_k<32>(grid, stream, p); break;
        case 6: launch_k<64>(grid, stream, p); break;
        case 7: launch_k<128>(grid, stream, p); break;
        case 8: launch_k<256>(grid, stream, p); break;
        case 9: launch_k<512>(grid, stream, p); break;
        default: launch_k<1024>(grid, stream, p); break;
        }
    }
#endif
}
```

```cpp
#include <hip/hip_runtime.h>
#include <hip/hip_cooperative_groups.h>
#include <cstdio>
namespace cg = cooperative_groups;

#ifndef N_LAUNCH_MODE
#define N_LAUNCH_MODE 1
#endif

#ifndef DUP_MASK
#define DUP_MASK 0
#endif
#ifndef EXTRA_SYNCS
#define EXTRA_SYNCS 0
#endif
#define LAS __attribute__((address_space(3)))
typedef _Float16 h16;
typedef _Float16 h16x8 __attribute__((ext_vector_type(8)));
typedef _Float16 h16x4 __attribute__((ext_vector_type(4)));
typedef _Float16 h16x2 __attribute__((ext_vector_type(2)));
typedef float f32x4 __attribute__((ext_vector_type(4)));
typedef float f32x2 __attribute__((ext_vector_type(2)));

constexpr int DM = 1024, TP = 16384, TS = 1024, T = TP + TS, DEPTH = 4;
constexpr int NSRC_IN = 8720, NPROJ = 8960, FFH = 2816;
constexpr int NTHREADS = 512, NWAVES = 8;
constexpr float ALPHA = 1.681792830507429f;
constexpr int C_AQ = 0, C_AF = 512, C_AI = 1024, C_AG = 1536, C_BQ = 2048, C_BK = 2304, C_BV = 2560, C_BO = 3072, C_CX = 3584, C_CG = 5120, C_MG = 5632, C_SM = 8704;

constexpr size_t SZ_WIN = (size_t)DEPTH * NPROJ * DM * 2, SZ_WBR = (size_t)DEPTH * 3072 * 512 * 2, SZ_WOUT = (size_t)DEPTH * DM * DM * 2,
                 SZ_WF1 = (size_t)DEPTH * 2 * FFH * DM * 2, SZ_WF2 = (size_t)DEPTH * DM * FFH * 2, SZ_LB = DEPTH * 512 * 4;
constexpr size_t WS_WIN = 0, WS_WBR = WS_WIN + SZ_WIN, WS_WOUT = WS_WBR + SZ_WBR, WS_WF1 = WS_WOUT + SZ_WOUT, WS_WF2 = WS_WF1 + SZ_WF1, WS_LB = WS_WF2 + SZ_WF2;
constexpr size_t WS_H32 = WS_LB + SZ_LB, WS_P = WS_H32 + (size_t)T * DM * 4, WS_G = WS_P + (size_t)T * NPROJ * 2, WS_R1 = WS_G + (size_t)T * 16 * 4,
                 WS_R2 = WS_R1 + (size_t)T * 1536 * 2, WS_BAR = WS_R2 + (size_t)T * 1536 * 4, WS_END = WS_BAR + 16384;
constexpr size_t O_Y = 0, O_HA_P = (size_t)T * DM, O_HA_S = O_HA_P + (size_t)DEPTH * 8 * 4 * 16384, O_MC_P = O_HA_S + (size_t)DEPTH * 128 * 4 * 16384,
                 O_MC_S = O_MC_P + (size_t)DEPTH * 8 * 4 * 8192, O_MN_P = O_MC_S + (size_t)DEPTH * 128 * 4 * 8192, O_MN_S = O_MN_P + DEPTH * 8 * 4 * 64,
                 O_MM_P = O_MN_S + DEPTH * 128 * 4 * 64, O_MM_S = O_MM_P + DEPTH * 8 * 4, O_G_P = O_MM_S + DEPTH * 128 * 4, O_G_S = O_G_P + (size_t)DEPTH * 8 * 4 * 16384,
                 O_CV_P = O_G_S + (size_t)DEPTH * 128 * 4 * 16384, O_CV_S = O_CV_P + (size_t)DEPTH * 8 * 3 * 1536, O_END = O_CV_S + (size_t)DEPTH * 128 * 3 * 1536;

struct P { const float* in[26]; float* out; unsigned char* ws; int lo, hi; };
enum { I_XP = 0, I_XS, I_SA, I_SC, I_SN, I_SM, I_SG, I_SV, I_WIN, I_LB, I_ANG, I_BMI, I_BMF, I_BNG, I_CW, I_ALOG, I_DTB, I_CNG, I_WBR, I_WOUT, I_L1G, I_L1B, I_WF1, I_WF2, I_L2G, I_L2B };

__device__ __forceinline__ int my_tid() { int t = threadIdx.x; asm volatile("" : "+v"(t)); return t; }
__device__ __forceinline__ int my_bid() { int b = blockIdx.x; asm volatile("" : "+s"(b)); return b; }
__device__ __forceinline__ int my_grid() { int g = gridDim.x; asm volatile("" : "+s"(g)); return g; }
__device__ __forceinline__ float sigm(float x) { return __builtin_amdgcn_rcpf(1.0f + __expf(-x)); }
__device__ __forceinline__ float silu(float x) { return x * sigm(x); }
template <int CTRL> __device__ __forceinline__ float dppf(float x) { return __builtin_bit_cast(float, __builtin_amdgcn_mov_dpp(__builtin_bit_cast(int, x), CTRL, 0xf, 0xf, true)); }
__device__ __forceinline__ float red16(float x) { x += dppf<0xB1>(x); x += dppf<0x4E>(x); x += dppf<0x124>(x); x += dppf<0x128>(x); return x; }
__device__ __forceinline__ float red64(float x) { x = red16(x); x += __shfl_xor(x, 16); x += __shfl_xor(x, 32); return x; }

namespace pg8 {
constexpr int BM = 256, BK = 64, HALF = 128, HTB = HALF * BK * 2, STAGE_BYTES = 8 * HTB, NXCD = 8, WGM = 8;
__device__ __forceinline__ int lds_byte(int r, int c) { const int st = (r >> 4) * 2 + (c >> 5), rr = r & 15, cc = c & 31, ob = rr * 64 + cc * 2; return st * 1024 + (ob ^ (((ob >> 9) & 1) << 5)); }
__device__ __forceinline__ void stage_rc(int b, int& R, int& C) { const int st = b / 1024, sb = b % 1024, swz = sb ^ (((sb >> 9) & 1) << 5); R = (st >> 1) * 16 + swz / 64; C = (st & 1) * 32 + (swz % 64) / 2; }
__device__ __forceinline__ int perm32(int rho) { const int n = rho >> 4, i = rho & 15; return 8 * (i >> 2) + 4 * n + (i & 3); }
struct Unit { int pm, pn; };
struct Gemm { const h16* A; const h16* Bt; int M, N, K; };
struct StaticOrder {
    int nM, nN, nwg, G, c;
    __device__ void init(int M, int N, int G_, int c_) { nM = M / BM; nN = N / BM; nwg = nM * nN; G = G_; c = c_; }
    __device__ bool next(int i, Unit& u) const {
        const long L = (long)i * G + c; if (L >= nwg) return false;
        int wgid = (int)L; { const int q = nwg / NXCD, r = nwg % NXCD, xcd = wgid % NXCD, off = wgid / NXCD; wgid = (xcd < r ? xcd * (q + 1) : r * (q + 1) + (xcd - r) * q) + off; }
        const int nig = WGM * nN, gid = wgid / nig, fm = gid * WGM, gsz = (nM - fm) < WGM ? (nM - fm) : WGM;
        u.pm = fm + ((wgid % nig) % gsz); u.pn = (wgid % nig) / gsz; return true;
    }
};
struct BranchOrder {
    int G, c;
    __device__ bool next(int i, Unit& u) const {
        const int ti = i / 3, br = i - 3 * ti; const int tile = ti * G + c; if (tile >= 64 * 4) return false;
        u.pm = (tile >> 2) + 68 * br; u.pn = (tile & 3) + 4 * br; return true;
    }
};

template <class Epi, class Sched>
__device__ __forceinline__ void gemm_phase(LAS unsigned char* lds, const Gemm g, const Sched& S, const Epi& E) {
    const int tid = my_tid(), wid = __builtin_amdgcn_readfirstlane(tid >> 6), lane = tid & 63, wr = wid >> 2, wc = wid & 3, fr = lane & 15, fq = lane >> 4;
    const int K = g.K, nt = K / BK;
    unsigned voffA[2], voffB[2];
#pragma unroll
    for (int i = 0; i < 2; ++i) { int R, C; stage_rc(tid * 16 + i * 8192, R, C); const int Rb = Epi::PERM ? ((R & ~31) + perm32(R & 31)) : R;
        voffA[i] = (unsigned)(R * K + C) * 2u; voffB[i] = (unsigned)(Rb * K + C) * 2u; }
    const size_t kstep = (size_t)(BK * 2);
    const size_t hstep = (size_t)HALF * K * 2;
    const size_t tstep = 2 * hstep;
    const unsigned ldsw = (unsigned)wid * 1024u;
    const int aoff = lds_byte(wr * 64 + fr, fq * 8), boff = lds_byte(wc * 32 + fr, fq * 8);
#define PG8_SA(b, h) (((b) * 2 + (h)) * HTB)
#define PG8_SB(b, h) ((4 + (b) * 2 + (h)) * HTB)
#define PG8_STAGE(bufoff, gbase, voff) do { _Pragma("unroll") for (int _i = 0; _i < 2; ++_i) \
        __builtin_amdgcn_global_load_lds((const unsigned*)((const char*)(gbase) + (voff)[_i]), (LAS unsigned*)(lds + (bufoff) + ldsw + _i * 8192), 16, 0, 0); } while (0)
#define PG8_LDA(dst, b, h) do { _Pragma("unroll") for (int m = 0; m < 4; ++m) _Pragma("unroll") for (int k = 0; k < 2; ++k) dst[m][k] = *(const LAS h16x8*)(lds + PG8_SA(b, h) + aoff + m * 2048 + k * 1024); } while (0)
#define PG8_LDB(dst, b, h) do { _Pragma("unroll") for (int n = 0; n < 2; ++n) _Pragma("unroll") for (int k = 0; k < 2; ++k) dst[n][k] = *(const LAS h16x8*)(lds + PG8_SB(b, h) + boff + n * 2048 + k * 1024); } while (0)
#define PG8_MMA(ai, bj, At, Bt) do { __builtin_amdgcn_s_setprio(1); _Pragma("unroll") for (int m = 0; m < 4; ++m) _Pragma("unroll") for (int n = 0; n < 2; ++n) _Pragma("unroll") for (int k = 0; k < 2; ++k) \
        acc[ai][bj][m][n] = __builtin_amdgcn_mfma_f32_16x16x32_f16(Bt[n][k], At[m][k], acc[ai][bj][m][n], 0, 0, 0); __builtin_amdgcn_s_setprio(0); } while (0)
#define PG8_WAIT_V(n) asm volatile("s_waitcnt vmcnt(" #n ")" ::: "memory")
#define PG8_WAIT_L(n) asm volatile("s_waitcnt lgkmcnt(" #n ")" ::: "memory")
#define PG8_BAR __builtin_amdgcn_s_barrier()
#define PG8_SCHED __builtin_amdgcn_sched_barrier(0)
    Unit cur, nxt; int ui = 0;
    if (!S.next(0, cur)) return;
    f32x4 acc[2][2][4][2];
#pragma unroll
    for (int a = 0; a < 2; ++a)
#pragma unroll
        for (int b = 0; b < 2; ++b)
#pragma unroll
            for (int m = 0; m < 4; ++m)
#pragma unroll
                for (int n = 0; n < 2; ++n) acc[a][b][m][n] = (f32x4){0.f, 0.f, 0.f, 0.f};
    h16x8 At[4][2], B0[2][2], B1[2][2];
    const char* cA = (const char*)g.A + (size_t)cur.pm * tstep; const char* cB = (const char*)g.Bt + (size_t)cur.pn * tstep;
    PG8_STAGE(PG8_SB(0, 0), cB, voffB); PG8_STAGE(PG8_SA(0, 0), cA, voffA); PG8_STAGE(PG8_SB(0, 1), cB + hstep, voffB); PG8_STAGE(PG8_SA(0, 1), cA + hstep, voffA);
    if (wr == 1) PG8_BAR;
    PG8_WAIT_V(4); PG8_BAR;
    PG8_STAGE(PG8_SB(1, 0), cB + kstep, voffB); PG8_STAGE(PG8_SA(1, 0), cA + kstep, voffA); PG8_STAGE(PG8_SB(1, 1), cB + hstep + kstep, voffB);
    PG8_WAIT_V(6); PG8_BAR;
    for (;;) {
        const bool has_next = S.next(ui + 1, nxt);
        const char* nA = has_next ? (const char*)g.A + (size_t)nxt.pm * tstep : cA; const char* nB = has_next ? (const char*)g.Bt + (size_t)nxt.pn * tstep : cB;
        for (int t = 0; t < nt; t += 2) {
            const bool last = (t == nt - 2);
            const char* a1 = cA + (size_t)(t + 1) * kstep;
            const char* a2 = last ? nA : cA + (size_t)(t + 2) * kstep; const char* b2 = last ? nB : cB + (size_t)(t + 2) * kstep;
            const char* a3 = a2 + kstep; const char* b3 = b2 + kstep;
            PG8_LDB(B0, 0, 0); PG8_SCHED; PG8_LDA(At, 0, 0); PG8_STAGE(PG8_SA(1, 1), a1 + hstep, voffA);
            PG8_WAIT_L(8); PG8_BAR; PG8_WAIT_L(0); PG8_MMA(0, 0, At, B0); PG8_BAR; PG8_SCHED;
            PG8_LDB(B1, 0, 1); PG8_STAGE(PG8_SB(0, 0), b2, voffB);
            PG8_BAR; PG8_WAIT_L(0); PG8_MMA(0, 1, At, B1); PG8_BAR;
            PG8_LDA(At, 0, 1); PG8_STAGE(PG8_SA(0, 0), a2, voffA);
            PG8_BAR; PG8_WAIT_L(0); PG8_MMA(1, 0, At, B0); PG8_BAR; PG8_SCHED;
            PG8_STAGE(PG8_SB(0, 1), b2 + hstep, voffB);
            PG8_WAIT_V(6); PG8_BAR; PG8_MMA(1, 1, At, B1); PG8_BAR;
            PG8_LDB(B0, 1, 0); PG8_SCHED; PG8_LDA(At, 1, 0); PG8_STAGE(PG8_SA(0, 1), a2 + hstep, voffA);
            PG8_WAIT_L(8); PG8_BAR; PG8_WAIT_L(0); PG8_MMA(0, 0, At, B0); PG8_BAR; PG8_SCHED;
            PG8_LDB(B1, 1, 1); PG8_STAGE(PG8_SB(1, 0), b3, voffB);
            PG8_BAR; PG8_WAIT_L(0); PG8_MMA(0, 1, At, B1); PG8_BAR;
            PG8_LDA(At, 1, 1); PG8_STAGE(PG8_SA(1, 0), a3, voffA);
            PG8_BAR; PG8_WAIT_L(0); PG8_MMA(1, 0, At, B0); PG8_BAR; PG8_SCHED;
            PG8_STAGE(PG8_SB(1, 1), b3 + hstep, voffB);
            PG8_WAIT_V(6); PG8_BAR; PG8_MMA(1, 1, At, B1); PG8_BAR;
        }
        E(acc, cur, wr, wc, fr, fq);
        if (!has_next) break;
        if constexpr (!Epi::KEEP_ACC) {
#pragma unroll
        for (int a = 0; a < 2; ++a)
#pragma unroll
            for (int b = 0; b < 2; ++b)
#pragma unroll
                for (int m = 0; m < 4; ++m)
#pragma unroll
                    for (int n = 0; n < 2; ++n) acc[a][b][m][n] = (f32x4){0.f, 0.f, 0.f, 0.f};
        }
        cur = nxt; cA = nA; cB = nB; ++ui;
    }
    PG8_WAIT_V(0);
    if (wr == 0) PG8_BAR;
    PG8_BAR;
#undef PG8_SA
#undef PG8_SB
#undef PG8_STAGE
#undef PG8_LDA
#undef PG8_LDB
#undef PG8_MMA
#undef PG8_WAIT_V
#undef PG8_WAIT_L
#undef PG8_BAR
#undef PG8_SCHED
}
}
using pg8::Unit;

__device__ __forceinline__ h16x8 pack8(const f32x4 a, const f32x4 b) {
    h16x8 o; o[0] = (h16)a[0]; o[1] = (h16)a[1]; o[2] = (h16)a[2]; o[3] = (h16)a[3]; o[4] = (h16)b[0]; o[5] = (h16)b[1]; o[6] = (h16)b[2]; o[7] = (h16)b[3]; return o;
}

struct EpiIn {
    static constexpr bool PERM = true, KEEP_ACC = false;
    h16* proj; float* gates; const float* lb; const float* b_mi; const float* b_mf; const float* a_log; const float* dt_bias;
    __device__ __forceinline__ void operator()(f32x4 (&acc)[2][2][4][2], const Unit& u, int wr, int wc, int fr, int fq) const {
        const int pn = u.pn; const int row0 = u.pm * 256 + wr * 64 + fr;
        if (pn == 34) {
            if (wc == 0 && fq < 2) {
                f32x4 c0, c1;
                if (fq == 0) { c0 = *(const f32x4*)b_mi; c1 = *(const f32x4*)b_mf; } else { c0 = *(const f32x4*)a_log; c1 = *(const f32x4*)dt_bias; }
#pragma unroll
                for (int ai = 0; ai < 2; ++ai)
#pragma unroll
                    for (int m = 0; m < 4; ++m) {
                        const f32x4 x0 = acc[ai][0][m][0], x1 = acc[ai][0][m][1]; f32x4 y0, y1;
#pragma unroll
                        for (int j = 0; j < 4; ++j) {
                            if (fq == 0) { y0[j] = x0[j] + c0[j]; const float z = x1[j] + c1[j]; y1[j] = fminf(z, 0.f) - log1pf(__expf(-fabsf(z))); }
                            else { y0[j] = sigm(x0[j]); const float z = x1[j] + c1[j]; y1[j] = -__expf(c0[j]) * (fmaxf(z, 0.f) + log1pf(__expf(-fabsf(z)))); }
                        }
                        float* gp = gates + (size_t)(row0 + ai * 128 + m * 16) * 16 + 8 * fq;
                        *(f32x4*)gp = y0; *(f32x4*)(gp + 4) = y1;
                    }
            }
            return;
        }
        int mode = 0;
        if (pn < 2) mode = 1; else if (pn < 4) mode = 3; else if (pn < 6) mode = 0; else if (pn < 8) mode = 1; else if (pn == 8) mode = 4; else if (pn < 12) mode = 0;
        else if (pn < 14) mode = 2; else if (pn < 20) mode = 0; else if (pn < 22) mode = 1; else mode = 2;
        const int col0 = pn * 256 + wc * 32 + 8 * fq;
        f32x4 lbv[2][2];
        if (mode == 3) {
#pragma unroll
            for (int bj = 0; bj < 2; ++bj)
#pragma unroll
                for (int n = 0; n < 2; ++n) lbv[bj][n] = 1.0f - *(const f32x4*)(lb + (col0 - C_AF) + bj * 128 + 4 * n);
        }
#pragma unroll
        for (int ai = 0; ai < 2; ++ai)
#pragma unroll
            for (int m = 0; m < 4; ++m) {
                h16* rowp = proj + (size_t)(row0 + ai * 128 + m * 16) * NPROJ + col0;
#pragma unroll
                for (int bj = 0; bj < 2; ++bj) {
                    f32x4 v[2] = {acc[ai][bj][m][0], acc[ai][bj][m][1]};
                    if (mode == 1) { for (int n = 0; n < 2; ++n) for (int j = 0; j < 4; ++j) v[n][j] = silu(v[n][j]); }
                    else if (mode == 2) { for (int n = 0; n < 2; ++n) for (int j = 0; j < 4; ++j) v[n][j] = fmaxf(sigm(v[n][j]), 6.2e-5f); }
                    else if (mode == 3) { for (int n = 0; n < 2; ++n) for (int j = 0; j < 4; ++j) v[n][j] = lbv[bj][n][j] * sigm(-v[n][j]); }
                    else if (mode == 4) { v[0] *= 0.125f; v[1] *= 0.125f; }
                    *(h16x8*)(rowp + bj * 128) = pack8(v[0], v[1]);
                }
            }
    }
};
struct EpiBranch {
    static constexpr bool PERM = true, KEEP_ACC = true;
    const h16* proj; h16* mrg16;
    __device__ __forceinline__ void operator()(f32x4 (&acc)[2][2][4][2], const Unit& u, int wr, int wc, int fr, int fq) const {
        const int br = u.pn >> 2; const int pn = u.pn & 3, pm = u.pm - 68 * br;
        const int row0 = pm * 256 + wr * 64 + fr, col0 = pn * 256 + wc * 32 + 8 * fq;
#pragma unroll
        for (int ai = 0; ai < 2; ++ai)
#pragma unroll
            for (int m = 0; m < 4; ++m) {
                const size_t row = (size_t)(row0 + ai * 128 + m * 16);
#pragma unroll
                for (int bj = 0; bj < 2; ++bj) {
                    const h16* gp = proj + row * NPROJ + C_MG + br * 1024 + col0 + bj * 128;
                    const h16x8 gc = *(const h16x8*)gp;
                    f32x4 v0 = acc[ai][bj][m][0], v1 = acc[ai][bj][m][1];
                    if (br < 2) {
                        const h16x8 gn = *(const h16x8*)(gp + 1024);
#pragma unroll
                        for (int j = 0; j < 4; ++j) { v0[j] *= (float)gc[j] * __builtin_amdgcn_rcpf((float)gn[j]); v1[j] *= (float)gc[4 + j] * __builtin_amdgcn_rcpf((float)gn[4 + j]); }
                        acc[ai][bj][m][0] = v0; acc[ai][bj][m][1] = v1;
                    } else {
#pragma unroll
                        for (int j = 0; j < 4; ++j) { v0[j] *= (float)gc[j]; v1[j] *= (float)gc[4 + j]; }
                        *(h16x8*)(mrg16 + row * DM + col0 + bj * 128) = pack8(v0, v1);
                        acc[ai][bj][m][0] = (f32x4){0.f, 0.f, 0.f, 0.f}; acc[ai][bj][m][1] = (f32x4){0.f, 0.f, 0.f, 0.f};
                    }
                }
            }
    }
};
struct EpiRes {
    static constexpr bool PERM = false, KEEP_ACC = false;
    const float* h32; float* pre32;
    __device__ __forceinline__ void operator()(f32x4 (&acc)[2][2][4][2], const Unit& u, int wr, int wc, int fr, int fq) const {
        const int row0 = u.pm * 256 + wr * 64 + fr, col0 = u.pn * 256 + wc * 32 + 4 * fq;
#pragma unroll
        for (int ai = 0; ai < 2; ++ai)
#pragma unroll
            for (int m = 0; m < 4; ++m) {
                const size_t off = (size_t)(row0 + ai * 128 + m * 16) * DM + col0;
#pragma unroll
                for (int bj = 0; bj < 2; ++bj)
#pragma unroll
                    for (int n = 0; n < 2; ++n) { const f32x4 hv = *(const f32x4*)(h32 + off + bj * 128 + n * 16); *(f32x4*)(pre32 + off + bj * 128 + n * 16) = ALPHA * hv + acc[ai][bj][m][n]; }
            }
    }
};
struct EpiSwiglu {
    static constexpr bool PERM = true, KEEP_ACC = false;
    h16* ff;
    __device__ __forceinline__ void operator()(f32x4 (&acc)[2][2][4][2], const Unit& u, int wr, int wc, int fr, int fq) const {
        const int row0 = u.pm * 256 + wr * 64 + fr, col0 = u.pn * 128 + wc * 32 + 8 * fq;
#pragma unroll
        for (int ai = 0; ai < 2; ++ai)
#pragma unroll
            for (int m = 0; m < 4; ++m) {
                f32x4 v[2];
#pragma unroll
                for (int n = 0; n < 2; ++n)
#pragma unroll
                    for (int j = 0; j < 4; ++j) v[n][j] = silu(acc[ai][0][m][n][j]) * acc[ai][1][m][n][j];
                *(h16x8*)(ff + (size_t)(row0 + ai * 128 + m * 16) * FFH + col0) = pack8(v[0], v[1]);
            }
    }
};

__device__ __forceinline__ void tail_kloop(const h16* __restrict__ ap, const h16* __restrict__ b0p, const h16* __restrict__ b1p, int K, f32x4& c0, f32x4& c1) {
#pragma unroll 8
    for (int k = 0; k < K; k += 32) {
        const h16x8 a = *(const h16x8*)(ap + k), b0 = *(const h16x8*)(b0p + k), b1 = *(const h16x8*)(b1p + k);
        c0 = __builtin_amdgcn_mfma_f32_16x16x32_f16(b0, a, c0, 0, 0, 0); c1 = __builtin_amdgcn_mfma_f32_16x16x32_f16(b1, a, c1, 0, 0, 0);
    }
}
__device__ void tail_res(const h16* A, int K, const h16* Bt, const float* h32, float* pre32) {
    const int tid = my_tid(), w = tid >> 6, lane = tid & 63, fr = lane & 15, fq = lane >> 4;
    for (int tile = my_bid(); tile < 256; tile += my_grid()) {
        const int row = TP + (tile >> 4) * 64 + (w >> 1) * 16 + fr, col0 = (tile & 15) * 64 + (w & 1) * 32;
        f32x4 c0 = {0.f, 0.f, 0.f, 0.f}, c1 = {0.f, 0.f, 0.f, 0.f};
        tail_kloop(A + (size_t)row * K + fq * 8, Bt + (size_t)(col0 + fr) * K + fq * 8, Bt + (size_t)(col0 + 16 + fr) * K + fq * 8, K, c0, c1);
        const size_t off = (size_t)row * DM + col0 + 4 * fq;
        *(f32x4*)(pre32 + off) = ALPHA * *(const f32x4*)(h32 + off) + c0; *(f32x4*)(pre32 + off + 16) = ALPHA * *(const f32x4*)(h32 + off + 16) + c1;
    }
}
__device__ void tail_branch(const h16* ys, const h16* Wbr, const h16* proj, h16* mrg16) {
    const int tid = my_tid(), w = tid >> 6, lane = tid & 63, fr = lane & 15, fq = lane >> 4;
    for (int tile = my_bid(); tile < 256; tile += my_grid()) {
        const int row = TP + (tile >> 4) * 64 + (w >> 1) * 16 + fr, col0 = (tile & 15) * 64 + (w & 1) * 32;
        f32x4 m0 = {0.f, 0.f, 0.f, 0.f}, m1 = {0.f, 0.f, 0.f, 0.f};
#pragma unroll 1
        for (int br = 0; br < 3; ++br) {
            f32x4 c0 = {0.f, 0.f, 0.f, 0.f}, c1 = {0.f, 0.f, 0.f, 0.f};
            const h16* Bt = Wbr + (size_t)br * 1024 * 512;
            tail_kloop(ys + ((size_t)br * T + row) * 512 + fq * 8, Bt + (size_t)(col0 + fr) * 512 + fq * 8, Bt + (size_t)(col0 + 16 + fr) * 512 + fq * 8, 512, c0, c1);
            const h16* gp = proj + (size_t)row * NPROJ + C_MG + br * 1024 + col0 + 4 * fq; const h16x4 g0 = *(const h16x4*)gp, g1 = *(const h16x4*)(gp + 16);
#pragma unroll
            for (int j = 0; j < 4; ++j) { m0[j] += (float)g0[j] * c0[j]; m1[j] += (float)g1[j] * c1[j]; }
        }
        h16x4 o0, o1;
#pragma unroll
        for (int j = 0; j < 4; ++j) { o0[j] = (h16)m0[j]; o1[j] = (h16)m1[j]; }
        h16* op = mrg16 + (size_t)row * DM + col0 + 4 * fq; *(h16x4*)op = o0; *(h16x4*)(op + 16) = o1;
    }
}

__device__ __forceinline__ int map_in(int n) {
    if (n < 3584) return n;
    if (n < 5632) return n + 8;
    if (n < 8704) return n + 16;
    if (n < 8708) return 3584 + (n - 8704);
    if (n < 8712) return 3588 + (n - 8708);
    if (n < 8716) return 5640 + (n - 8712);
    if (n < 8720) return 5644 + (n - 8716);
    return -1;
}
__device__ __forceinline__ int map_f1(int n) { const int p = n >> 8, w = n & 255; return w < 128 ? 128 * p + w : FFH + 128 * p + (w - 128); }
__device__ __forceinline__ void tr_tile(const float* __restrict__ src, int Nsrc, h16* __restrict__ dst, int K, int n0, int k0, int mapid, LAS float* tile) {
    const int tid = my_tid(), tx = tid & 63, ty = tid >> 6;
    const int n = n0 + tx; const int sc = mapid == 0 ? n : (mapid == 1 ? map_in(n) : map_f1(n));
#pragma unroll
    for (int p = 0; p < 8; ++p) { const int k = ty + 8 * p; tile[k * 65 + tx] = sc >= 0 ? src[(size_t)(k0 + k) * Nsrc + sc] : 0.f; }
    __syncthreads();
    const int kx = (tid & 31) * 2, ny = tid >> 5;
#pragma unroll
    for (int p = 0; p < 4; ++p) { const int nn = ny + 16 * p; h16x2 o; o[0] = (h16)tile[kx * 65 + nn]; o[1] = (h16)tile[(kx + 1) * 65 + nn]; *(h16x2*)(dst + (size_t)(n0 + nn) * K + k0 + kx) = o; }
    __syncthreads();
}
__device__ void phase_prep(const P& p, LAS unsigned char* lds) {
    LAS float* tile = (LAS float*)lds;
    unsigned char* ws = p.ws;
    constexpr int T_IN = (NPROJ / 64) * (DM / 64), T_BR = 3 * (1024 / 64) * (512 / 64), T_OUT = 16 * 16, T_F1 = (2 * FFH / 64) * 16, T_F2 = 16 * (FFH / 64), T_L = T_IN + T_BR + T_OUT + T_F1 + T_F2;
    for (int id = my_bid(); id < DEPTH * T_L; id += my_grid()) {
        const int l = id / T_L; int r = id - l * T_L;
        if (r < T_IN) { const int tn = r / 16, tk = r % 16; tr_tile(p.in[I_WIN] + (size_t)l * DM * NSRC_IN, NSRC_IN, (h16*)(ws + WS_WIN) + (size_t)l * NPROJ * DM, DM, tn * 64, tk * 64, 1, tile); continue; }
        r -= T_IN;
        if (r < T_BR) { const int br = r / 128, q = r % 128, tn = q / 8, tk = q % 8; tr_tile(p.in[I_WBR] + ((size_t)l * 3 + br) * 512 * 1024, 1024, (h16*)(ws + WS_WBR) + ((size_t)l * 3 + br) * 1024 * 512, 512, tn * 64, tk * 64, 0, tile); continue; }
        r -= T_BR;
        if (r < T_OUT) { const int tn = r / 16, tk = r % 16; tr_tile(p.in[I_WOUT] + (size_t)l * DM * DM, DM, (h16*)(ws + WS_WOUT) + (size_t)l * DM * DM, DM, tn * 64, tk * 64, 0, tile); continue; }
        r -= T_OUT;
        if (r < T_F1) { const int tn = r / 16, tk = r % 16; tr_tile(p.in[I_WF1] + (size_t)l * DM * 2 * FFH, 2 * FFH, (h16*)(ws + WS_WF1) + (size_t)l * 2 * FFH * DM, DM, tn * 64, tk * 64, 2, tile); continue; }
        r -= T_F1;
        { const int tn = r / (FFH / 64), tk = r % (FFH / 64); tr_tile(p.in[I_WF2] + (size_t)l * FFH * DM, DM, (h16*)(ws + WS_WF2) + (size_t)l * DM * FFH, FFH, tn * 64, tk * 64, 0, tile); }
    }
    if (my_bid() == 0) {
        const int c = my_tid(); const float* lg = p.in[I_LB];
        const float a0 = lg[c], a1 = lg[512 + c], a2 = lg[1024 + c], a3 = lg[1536 + c]; const float mx = fmaxf(fmaxf(a0, a1), fmaxf(a2, a3));
        const float e0 = expf(a0 - mx), e1 = expf(a1 - mx), e2 = expf(a2 - mx), e3 = expf(a3 - mx), inv = 1.0f / (e0 + e1 + e2 + e3);
        float* lb = (float*)(ws + WS_LB); lb[c] = 0.f; lb[512 + c] = e1 * inv; lb[1024 + c] = (e1 + e2) * inv; lb[1536 + c] = (e1 + e2 + e3) * inv;
    }
    float* h32 = (float*)(ws + WS_H32); h16* hh = (h16*)(ws + WS_R1);
    const size_t n4 = (size_t)T * DM / 4, np4 = (size_t)TP * DM / 4;
    for (size_t i = (size_t)my_bid() * NTHREADS + my_tid(); i < n4; i += (size_t)my_grid() * NTHREADS) {
        const f32x4 v = i < np4 ? ((const f32x4*)p.in[I_XP])[i] : ((const f32x4*)p.in[I_XS])[i - np4];
        ((f32x4*)h32)[i] = v; h16x4 o; o[0] = (h16)v[0]; o[1] = (h16)v[1]; o[2] = (h16)v[2]; o[3] = (h16)v[3]; ((h16x4*)hh)[i] = o;
    }
}

__device__ void phase_conv(const P& p, int l) {
    const int lane = my_tid() & 63, wv = my_tid() >> 6, seg = lane & 15, hg = lane >> 4;
    const h16* proj = (const h16*)(p.ws + WS_P); h16* cprep = (h16*)(p.ws + WS_R1);
    const float* cw = p.in[I_CW] + (size_t)l * 4 * 1536;
    for (int r = my_bid() + my_grid() * wv; r < T; r += my_grid() * NWAVES) {
        int b, pos, L, grp; if (r < TP) { grp = 0; b = r >> 11; pos = r & 2047; L = 2048; } else { grp = 1; b = (r - TP) >> 3; pos = (r - TP) & 7; L = 8; }
#pragma unroll 1
        for (int it = 0; it < 3; ++it) {
            const int c = it * 512 + hg * 128 + seg * 8;
            float a[8];
#pragma unroll
            for (int j = 0; j < 8; ++j) a[j] = 0.f;
            h16x8 xc;
#pragma unroll
            for (int d = 0; d < 4; ++d) {
                float xv[8]; bool have = true;
                if (pos - d >= 0) { const h16x8 x = *(const h16x8*)(proj + (size_t)(r - d) * NPROJ + C_CX + c); if (d == 0) xc = x;
#pragma unroll
                    for (int j = 0; j < 8; ++j) xv[j] = (float)x[j]; }
                else if (grp) { const float* sp = p.in[I_SV] + (((size_t)l * 128 + b) * 3 + (3 + pos - d)) * 1536 + c; const f32x4 s0 = *(const f32x4*)sp, s1 = *(const f32x4*)(sp + 4);
#pragma unroll
                    for (int j = 0; j < 4; ++j) { xv[j] = s0[j]; xv[4 + j] = s1[j]; } }
                else have = false;
                if (have) { const f32x4 w0 = *(const f32x4*)(cw + (3 - d) * 1536 + c), w1 = *(const f32x4*)(cw + (3 - d) * 1536 + c + 4);
#pragma unroll
                    for (int j = 0; j < 4; ++j) { a[j] += xv[j] * w0[j]; a[4 + j] += xv[4 + j] * w1[j]; } }
            }
            float ss = 0.f;
#pragma unroll
            for (int j = 0; j < 8; ++j) { a[j] = silu(a[j]); ss += a[j] * a[j]; }
            if (it < 2) { ss = red16(ss); const float sc = rsqrtf(ss + 1e-6f) * (it == 0 ? 0.08838834764831845f : 1.0f);
#pragma unroll
                for (int j = 0; j < 8; ++j) a[j] *= sc; }
            h16x8 o;
#pragma unroll
            for (int j = 0; j < 8; ++j) o[j] = (h16)a[j];
            *(h16x8*)(cprep + (size_t)r * 1536 + c) = o;
            if (pos >= L - 3) {
                float* op = p.out + (grp ? O_CV_S + (((size_t)l * 128 + b) * 3 + (pos - (L - 3))) * 1536 : O_CV_P + (((size_t)l * 8 + b) * 3 + (pos - (L - 3))) * 1536) + c;
                f32x4 o0, o1;
#pragma unroll
                for (int j = 0; j < 4; ++j) { o0[j] = (float)xc[j]; o1[j] = (float)xc[4 + j]; }
                *(f32x4*)op = o0; *(f32x4*)(op + 4) = o1;
            }
        }
    }
}

template <int NC> __device__ __forceinline__ void ld_h(const h16* p, float (&v)[NC]) {
    if constexpr (NC == 2) { const h16x2 x = *(const h16x2*)p; v[0] = (float)x[0]; v[1] = (float)x[1]; }
    else { const h16x8 x = *(const h16x8*)p;
#pragma unroll
        for (int j = 0; j < 8; ++j) v[j] = (float)x[j]; }
}
template <int NC> __device__ __forceinline__ void st_f(float* p, const float (&v)[NC]) {
    if constexpr (NC == 2) { *(f32x2*)p = (f32x2){v[0], v[1]}; }
    else { *(f32x4*)p = (f32x4){v[0], v[1], v[2], v[3]}; *(f32x4*)(p + 4) = (f32x4){v[4], v[5], v[6], v[7]}; }
}
template <int NC> __device__ __forceinline__ void ld_f(const float* p, float (&v)[NC]) {
    if constexpr (NC == 2) { const f32x2 x = *(const f32x2*)p; v[0] = x[0]; v[1] = x[1]; }
    else { const f32x4 x = *(const f32x4*)p, y = *(const f32x4*)(p + 4);
#pragma unroll
        for (int j = 0; j < 4; ++j) { v[j] = x[j]; v[4 + j] = y[j]; } }
}

template <int NC> __device__ void scanA(const P& p, int l, int grp, int b, int h, int unit, int lane) {
    const int seg = lane & 15, cgp = lane >> 4; const int L = grp ? 8 : 2048; const size_t row0 = grp ? (size_t)TP + b * 8 : (size_t)b * 2048;
    const int c0 = unit * (4 * NC) + cgp * NC;
    float S[8][NC];
    const size_t sidx = (size_t)h * 16384 + (size_t)(8 * seg) * 128 + c0;
    if (grp) { const float* sp = p.in[I_SA] + ((size_t)l * 128 + b) * 65536 + sidx;
#pragma unroll
        for (int r = 0; r < 8; ++r) ld_f<NC>(sp + r * 128, S[r]); }
    else {
#pragma unroll
        for (int r = 0; r < 8; ++r)
#pragma unroll
            for (int j = 0; j < NC; ++j) S[r][j] = 0.f; }
    const h16* base = (const h16*)(p.ws + WS_P) + row0 * NPROJ + h * 128;
    float* ob = (float*)(p.ws + WS_R2) + row0 * 1536 + h * 128 + c0;
    h16x8 qn = *(const h16x8*)(base + C_AQ + 8 * seg), kn = *(const h16x8*)(base + C_AF + 8 * seg); float vn[NC]; ld_h<NC>(base + C_AI + c0, vn);
#pragma unroll 1
    for (int t = 0; t < L; ++t) {
        const h16x8 q8 = qn, k8 = kn; float v[NC];
#pragma unroll
        for (int j = 0; j < NC; ++j) v[j] = vn[j];
        if (t + 1 < L) { const h16* nb = base + (size_t)(t + 1) * NPROJ; qn = *(const h16x8*)(nb + C_AQ + 8 * seg); kn = *(const h16x8*)(nb + C_AF + 8 * seg); ld_h<NC>(nb + C_AI + c0, vn); }
        float o[NC];
#pragma unroll
        for (int j = 0; j < NC; ++j) o[j] = 0.f;
#pragma unroll
        for (int r = 0; r < 8; ++r) { const float kk = (float)k8[r], qq = (float)q8[r];
#pragma unroll
            for (int j = 0; j < NC; ++j) { S[r][j] += kk * (v[j] - S[r][j]); o[j] += S[r][j] * qq; } }
#pragma unroll
        for (int j = 0; j < NC; ++j) o[j] = red16(o[j]);
        if (seg == 0) st_f<NC>(ob + (size_t)t * 1536, o);
    }
    float* op = p.out + (grp ? O_HA_S + ((size_t)l * 128 + b) * 65536 : O_HA_P + ((size_t)l * 8 + b) * 65536) + sidx;
#pragma unroll
    for (int r = 0; r < 8; ++r) st_f<NC>(op + r * 128, S[r]);
}
template <int NC> __device__ void scanC(const P& p, int l, int grp, int b, int h, int unit, int lane) {
    const int seg = lane & 15, cgp = lane >> 4; const int L = grp ? 8 : 2048; const size_t row0 = grp ? (size_t)TP + b * 8 : (size_t)b * 2048;
    const int c0 = unit * (4 * NC) + cgp * NC;
    float S[8][NC];
    const size_t sidx = (size_t)h * 16384 + (size_t)(8 * seg) * 128 + c0;
    if (grp) { const float* sp = p.in[I_SG] + ((size_t)l * 128 + b) * 65536 + sidx;
#pragma unroll
        for (int r = 0; r < 8; ++r) ld_f<NC>(sp + r * 128, S[r]); }
    else {
#pragma unroll
        for (int r = 0; r < 8; ++r)
#pragma unroll
            for (int j = 0; j < NC; ++j) S[r][j] = 0.f; }
    const h16* base = (const h16*)(p.ws + WS_R1) + row0 * 1536 + h * 128;
    const float* gt = (const float*)(p.ws + WS_G) + row0 * 16 + h;
    float* ob = (float*)(p.ws + WS_R2) + row0 * 1536 + 1024 + h * 128 + c0;
    h16x8 qn = *(const h16x8*)(base + 8 * seg), kn = *(const h16x8*)(base + 512 + 8 * seg); float vn[NC]; ld_h<NC>(base + 1024 + c0, vn);
    float betan = gt[8], gn = gt[12];
#pragma unroll 1
    for (int t = 0; t < L; ++t) {
        const h16x8 q8 = qn, k8 = kn; float v[NC]; const float beta = betan, a = __expf(gn);
#pragma unroll
        for (int j = 0; j < NC; ++j) v[j] = vn[j];
        if (t + 1 < L) { const h16* nb = base + (size_t)(t + 1) * 1536; qn = *(const h16x8*)(nb + 8 * seg); kn = *(const h16x8*)(nb + 512 + 8 * seg); ld_h<NC>(nb + 1024 + c0, vn);
            betan = gt[(size_t)(t + 1) * 16 + 8]; gn = gt[(size_t)(t + 1) * 16 + 12]; }
        float kf[8], qf[8];
#pragma unroll
        for (int r = 0; r < 8; ++r) { kf[r] = (float)k8[r]; qf[r] = (float)q8[r]; }
        float u[NC];
#pragma unroll
        for (int j = 0; j < NC; ++j) u[j] = 0.f;
#pragma unroll
        for (int r = 0; r < 8; ++r)
#pragma unroll
            for (int j = 0; j < NC; ++j) u[j] += S[r][j] * kf[r];
        float o[NC];
#pragma unroll
        for (int j = 0; j < NC; ++j) { u[j] = red16(u[j]); u[j] = beta * (v[j] - a * u[j]); o[j] = 0.f; }
#pragma unroll
        for (int r = 0; r < 8; ++r)
#pragma unroll
            for (int j = 0; j < NC; ++j) { S[r][j] = a * S[r][j] + kf[r] * u[j]; o[j] += S[r][j] * qf[r]; }
#pragma unroll
        for (int j = 0; j < NC; ++j) o[j] = red16(o[j]);
        if (seg == 0) st_f<NC>(ob + (size_t)t * 1536, o);
    }
    float* op = p.out + (grp ? O_G_S + ((size_t)l * 128 + b) * 65536 : O_G_P + ((size_t)l * 8 + b) * 65536) + sidx;
#pragma unroll
    for (int r = 0; r < 8; ++r) st_f<NC>(op + r * 128, S[r]);
}
template <int NV> __device__ void scanB(const P& p, int l, int grp, int b, int h, int unit, int lane) {
    const int seg = lane & 15, vg = lane >> 4; const int L = grp ? 8 : 2048; const size_t row0 = grp ? (size_t)TP + b * 8 : (size_t)b * 2048;
    const int v0 = unit * (4 * NV) + vg * NV;
    float C[NV][4], nn[4], m;
    const size_t cidx = (size_t)h * 8192 + (size_t)v0 * 64 + 4 * seg;
    if (grp) { const float* sp = p.in[I_SC] + ((size_t)l * 128 + b) * 32768 + cidx;
#pragma unroll
        for (int i = 0; i < NV; ++i) { const f32x4 x = *(const f32x4*)(sp + i * 64); C[i][0] = x[0]; C[i][1] = x[1]; C[i][2] = x[2]; C[i][3] = x[3]; }
        const f32x4 x = *(const f32x4*)(p.in[I_SN] + (((size_t)l * 128 + b) * 4 + h) * 64 + 4 * seg); nn[0] = x[0]; nn[1] = x[1]; nn[2] = x[2]; nn[3] = x[3];
        m = p.in[I_SM][((size_t)l * 128 + b) * 4 + h]; }
    else {
#pragma unroll
        for (int i = 0; i < NV; ++i) { C[i][0] = 0.f; C[i][1] = 0.f; C[i][2] = 0.f; C[i][3] = 0.f; }
        nn[0] = nn[1] = nn[2] = nn[3] = 0.f; m = 0.f; }
    const h16* base = (const h16*)(p.ws + WS_P) + row0 * NPROJ;
    const float* gt = (const float*)(p.ws + WS_G) + row0 * 16 + h;
    float* ob = (float*)(p.ws + WS_R2) + row0 * 1536 + 512 + h * 128 + v0;
    h16x4 qn = *(const h16x4*)(base + C_BQ + h * 64 + 4 * seg), kn = *(const h16x4*)(base + C_BK + h * 64 + 4 * seg); float vn[NV]; ld_h<NV>(base + C_BV + h * 128 + v0, vn);
    float ign = gt[0], lfn = gt[4];
#pragma unroll 1
    for (int t = 0; t < L; ++t) {
        const h16x4 q4 = qn, k4 = kn; float v[NV]; const float ig = ign, lf = lfn;
#pragma unroll
        for (int i = 0; i < NV; ++i) v[i] = vn[i];
        if (t + 1 < L) { const h16* nb = base + (size_t)(t + 1) * NPROJ; qn = *(const h16x4*)(nb + C_BQ + h * 64 + 4 * seg); kn = *(const h16x4*)(nb + C_BK + h * 64 + 4 * seg); ld_h<NV>(nb + C_BV + h * 128 + v0, vn);
            ign = gt[(size_t)(t + 1) * 16]; lfn = gt[(size_t)(t + 1) * 16 + 4]; }
        const float mn = fmaxf(lf + m, ig), wo = __expf(lf + m - mn), wi = __expf(ig - mn); m = mn;
        float kf[4], qf[4];
#pragma unroll
        for (int r = 0; r < 4; ++r) { kf[r] = (float)k4[r]; qf[r] = (float)q4[r]; }
        float den = 0.f;
#pragma unroll
        for (int r = 0; r < 4; ++r) { nn[r] = wo * nn[r] + wi * kf[r]; den += nn[r] * qf[r]; }
        float num[NV];
#pragma unroll
        for (int i = 0; i < NV; ++i) { const float wv = wi * v[i]; num[i] = 0.f;
#pragma unroll
            for (int r = 0; r < 4; ++r) { C[i][r] = wo * C[i][r] + wv * kf[r]; num[i] += C[i][r] * qf[r]; } }
        den = red16(den);
        const float inv = 1.0f / fmaxf(fabsf(den), __expf(-m));
#pragma unroll
        for (int i = 0; i < NV; ++i) num[i] = red16(num[i]) * inv;
        if (seg == 0) st_f<NV>(ob + (size_t)t * 1536, num);
    }
    float* op = p.out + (grp ? O_MC_S + ((size_t)l * 128 + b) * 32768 : O_MC_P + ((size_t)l * 8 + b) * 32768) + cidx;
#pragma unroll
    for (int i = 0; i < NV; ++i) *(f32x4*)(op + i * 64) = (f32x4){C[i][0], C[i][1], C[i][2], C[i][3]};
    if (unit == 0 && vg == 0) {
        const size_t bh = grp ? ((size_t)l * 128 + b) * 4 + h : ((size_t)l * 8 + b) * 4 + h;
        *(f32x4*)(p.out + (grp ? O_MN_S : O_MN_P) + bh * 64 + 4 * seg) = (f32x4){nn[0], nn[1], nn[2], nn[3]};
        if (seg == 0) p.out[(grp ? O_MM_S : O_MM_P) + bh] = m;
    }
}
__device__ __forceinline__ void cvt8(const h16x8 x, LAS float* d) {
    *(LAS f32x4*)d = (f32x4){(float)x[0], (float)x[1], (float)x[2], (float)x[3]}; *(LAS f32x4*)(d + 4) = (f32x4){(float)x[4], (float)x[5], (float)x[6], (float)x[7]};
}
constexpr int PB = 8, NPB = 2048 / PB;
struct PScanA {
    static constexpr int REC = 272;
    struct Stg { h16x8 q[2], k[2], v; };
    const h16* base; int lane, seg, cgp; f32x2 S[8][2]; float* ob;
    __device__ __forceinline__ void init(const P& p, int l, int b, int h, int unit, int lane_) {
        lane = lane_; seg = lane & 15; cgp = lane >> 4;
        base = (const h16*)(p.ws + WS_P) + (size_t)b * 2048 * NPROJ + h * 128; ob = (float*)(p.ws + WS_R2) + (size_t)b * 2048 * 1536 + h * 128 + unit * 16 + cgp * 4;
        base += unit * 16;
#pragma unroll
        for (int r = 0; r < 8; ++r) { S[r][0] = (f32x2){0.f, 0.f}; S[r][1] = (f32x2){0.f, 0.f}; }
        u16 = unit * 16;
    }
    int u16;
    __device__ __forceinline__ void issue(int blk, Stg& s) const {
        blk = blk < NPB ? blk : NPB - 1;
#pragma unroll
        for (int i = 0; i < 2; ++i) { const h16* rp = base - u16 + (size_t)(blk * PB + (lane >> 4) + 4 * i) * NPROJ + (lane & 15) * 8; s.q[i] = *(const h16x8*)(rp + C_AQ); s.k[i] = *(const h16x8*)(rp + C_AF); }
        if (lane < 16) s.v = *(const h16x8*)(base + (size_t)(blk * PB + (lane >> 1)) * NPROJ + C_AI + (lane & 1) * 8);
    }
    __device__ __forceinline__ void write(const Stg& s, LAS float* slot) const {
#pragma unroll
        for (int i = 0; i < 2; ++i) { LAS float* d = slot + ((lane >> 4) + 4 * i) * REC + (lane & 15) * 8; cvt8(s.q[i], d); cvt8(s.k[i], d + 128); }
        if (lane < 16) cvt8(s.v, slot + (lane >> 1) * REC + 256 + (lane & 1) * 8);
    }
    struct In { f32x4 q0, q1, k0, k1, v4; };
    __device__ __forceinline__ void load(const LAS float* rec, In& x) const {
        x.q0 = *(const LAS f32x4*)(rec + 4 * seg); x.q1 = *(const LAS f32x4*)(rec + 64 + 4 * seg); x.k0 = *(const LAS f32x4*)(rec + 128 + 4 * seg); x.k1 = *(const LAS f32x4*)(rec + 192 + 4 * seg);
        x.v4 = *(const LAS f32x4*)(rec + 256 + 4 * cgp);
    }
    __device__ __forceinline__ void step(const In& x, int t) {
        const f32x4 q0 = x.q0, q1 = x.q1, k0 = x.k0, k1 = x.k1, v4 = x.v4;
        const f32x2 va = {v4[0], v4[1]}, vb = {v4[2], v4[3]};
        f32x2 oa = {0.f, 0.f}, obb = {0.f, 0.f};
#pragma unroll
        for (int r = 0; r < 8; ++r) { const float kk = r < 4 ? k0[r & 3] : k1[r & 3], qq = r < 4 ? q0[r & 3] : q1[r & 3];
            S[r][0] = S[r][0] + kk * (va - S[r][0]); S[r][1] = S[r][1] + kk * (vb - S[r][1]); oa = oa + S[r][0] * qq; obb = obb + S[r][1] * qq; }
        const f32x4 o = {red16(oa[0]), red16(oa[1]), red16(obb[0]), red16(obb[1])};
        const bool mine = seg == (t & (PB - 1));
        ko[0] = mine ? o[0] : ko[0]; ko[1] = mine ? o[1] : ko[1]; ko[2] = mine ? o[2] : ko[2]; ko[3] = mine ? o[3] : ko[3];
    }
    f32x4 ko;
    __device__ __forceinline__ void flush(int t0) { if (seg < PB) *(f32x4*)(ob + (size_t)(t0 + seg) * 1536) = ko; }
    __device__ __forceinline__ void finish(const P& p, int l, int b, int h, int unit) const {
        float* op = p.out + O_HA_P + (((size_t)l * 8 + b) * 4 + h) * 16384 + unit * 16 + cgp * 4;
#pragma unroll
        for (int r = 0; r < 8; ++r) { const int row = (r >> 2) * 64 + 4 * seg + (r & 3); *(f32x4*)(op + (size_t)row * 128) = (f32x4){S[r][0][0], S[r][0][1], S[r][1][0], S[r][1][1]}; }
    }
};
struct PScanC {
    static constexpr int REC = 268;
    struct Stg { h16x8 q[2], k[2], v; float beta, g; };
    const h16* base; const float* gt; int lane, seg, cgp, u8; f32x2 S[8]; float* ob;
    __device__ __forceinline__ void init(const P& p, int l, int b, int h, int unit, int lane_) {
        lane = lane_; seg = lane & 15; cgp = lane >> 4; u8 = unit * 8;
        base = (const h16*)(p.ws + WS_R1) + (size_t)b * 2048 * 1536 + h * 128; gt = (const float*)(p.ws + WS_G) + (size_t)b * 2048 * 16 + h;
        ob = (float*)(p.ws + WS_R2) + (size_t)b * 2048 * 1536 + 1024 + h * 128 + u8 + cgp * 2;
#pragma unroll
        for (int r = 0; r < 8; ++r) S[r] = (f32x2){0.f, 0.f};
    }
    __device__ __forceinline__ void issue(int blk, Stg& s) const {
        blk = blk < NPB ? blk : NPB - 1;
#pragma unroll
        for (int i = 0; i < 2; ++i) { const h16* rp = base + (size_t)(blk * PB + (lane >> 4) + 4 * i) * 1536 + (lane & 15) * 8; s.q[i] = *(const h16x8*)rp; s.k[i] = *(const h16x8*)(rp + 512); }
        if (lane < 8) { const size_t row = (size_t)(blk * PB + lane); s.v = *(const h16x8*)(base + row * 1536 + 1024 + u8); s.beta = gt[row * 16 + 8]; s.g = gt[row * 16 + 12]; }
    }
    __device__ __forceinline__ void write(const Stg& s, LAS float* slot) const {
#pragma unroll
        for (int i = 0; i < 2; ++i) { LAS float* d = slot + ((lane >> 4) + 4 * i) * REC + (lane & 15) * 8; cvt8(s.q[i], d); cvt8(s.k[i], d + 128); }
        if (lane < 8) { LAS float* d = slot + lane * REC + 256; cvt8(s.v, d); *(LAS f32x2*)(d + 8) = (f32x2){s.beta, __expf(s.g)}; }
    }
    struct In { f32x4 q0, q1, k0, k1; f32x2 v2, ba; };
    __device__ __forceinline__ void load(const LAS float* rec, In& x) const {
        x.q0 = *(const LAS f32x4*)(rec + 4 * seg); x.q1 = *(const LAS f32x4*)(rec + 64 + 4 * seg); x.k0 = *(const LAS f32x4*)(rec + 128 + 4 * seg); x.k1 = *(const LAS f32x4*)(rec + 192 + 4 * seg);
        x.v2 = *(const LAS f32x2*)(rec + 256 + 2 * cgp); x.ba = *(const LAS f32x2*)(rec + 264);
    }
    __device__ __forceinline__ void step(const In& x, int t) {
        const f32x4 q0 = x.q0, q1 = x.q1, k0 = x.k0, k1 = x.k1; const f32x2 v2 = x.v2, ba = x.ba;
        f32x2 u = {0.f, 0.f};
#pragma unroll
        for (int r = 0; r < 8; ++r) { const float kk = r < 4 ? k0[r & 3] : k1[r & 3]; u = u + S[r] * kk; }
        u[0] = red16(u[0]); u[1] = red16(u[1]);
        const float beta = ba[0], a = ba[1];
        const f32x2 vn = beta * (v2 - a * u);
        f32x2 o = {0.f, 0.f};
#pragma unroll
        for (int r = 0; r < 8; ++r) { const float kk = r < 4 ? k0[r & 3] : k1[r & 3], qq = r < 4 ? q0[r & 3] : q1[r & 3]; S[r] = a * S[r] + kk * vn; o = o + S[r] * qq; }
        o[0] = red16(o[0]); o[1] = red16(o[1]);
        const bool mine = seg == (t & (PB - 1));
        ko[0] = mine ? o[0] : ko[0]; ko[1] = mine ? o[1] : ko[1];
    }
    f32x2 ko;
    __device__ __forceinline__ void flush(int t0) { if (seg < PB) *(f32x2*)(ob + (size_t)(t0 + seg) * 1536) = ko; }
    __device__ __forceinline__ void finish(const P& p, int l, int b, int h, int unit) const {
        float* op = p.out + O_G_P + (((size_t)l * 8 + b) * 4 + h) * 16384 + u8 + cgp * 2;
#pragma unroll
        for (int r = 0; r < 8; ++r) { const int row = (r >> 2) * 64 + 4 * seg + (r & 3); *(f32x2*)(op + (size_t)row * 128) = S[r]; }
    }
};
struct PScanB {
    static constexpr int REC = 148;
    struct Stg { h16x8 q, k, v; float ig, lf; };
    const h16* base; const float* gt; int lane, seg, vg, u16; f32x2 C[4][2], nn[2]; float m; float* ob;
    __device__ __forceinline__ void init(const P& p, int l, int b, int h, int unit, int lane_) {
        lane = lane_; seg = lane & 15; vg = lane >> 4; u16 = unit * 16;
        base = (const h16*)(p.ws + WS_P) + (size_t)b * 2048 * NPROJ; gt = (const float*)(p.ws + WS_G) + (size_t)b * 2048 * 16 + h;
        hq = h * 64; hv = h * 128 + u16;
        ob = (float*)(p.ws + WS_R2) + (size_t)b * 2048 * 1536 + 512 + h * 128 + u16 + vg * 4;
#pragma unroll
        for (int i = 0; i < 4; ++i) { C[i][0] = (f32x2){0.f, 0.f}; C[i][1] = (f32x2){0.f, 0.f}; }
        nn[0] = (f32x2){0.f, 0.f}; nn[1] = (f32x2){0.f, 0.f}; m = 0.f;
    }
    int hq, hv;
    __device__ __forceinline__ void issue(int blk, Stg& s) const {
        blk = blk < NPB ? blk : NPB - 1;
        { const h16* rp = base + (size_t)(blk * PB + (lane >> 3)) * NPROJ + hq + (lane & 7) * 8; s.q = *(const h16x8*)(rp + C_BQ); s.k = *(const h16x8*)(rp + C_BK); }
        if (lane < 16) s.v = *(const h16x8*)(base + (size_t)(blk * PB + (lane >> 1)) * NPROJ + C_BV + hv + (lane & 1) * 8);
        if (lane < 8) { const size_t row = (size_t)(blk * PB + lane); s.ig = gt[row * 16]; s.lf = gt[row * 16 + 4]; }
    }
    __device__ __forceinline__ void write(const Stg& s, LAS float* slot) const {
        { LAS float* d = slot + (lane >> 3) * REC + (lane & 7) * 8; cvt8(s.q, d); cvt8(s.k, d + 64); }
        if (lane < 16) cvt8(s.v, slot + (lane >> 1) * REC + 128 + (lane & 1) * 8);
        if (lane < 8) *(LAS f32x2*)(slot + lane * REC + 144) = (f32x2){s.ig, s.lf};
    }
    struct In { f32x4 q4, k4, v4; f32x2 gl; };
    __device__ __forceinline__ void load(const LAS float* rec, In& x) const {
        x.q4 = *(const LAS f32x4*)(rec + 4 * seg); x.k4 = *(const LAS f32x4*)(rec + 64 + 4 * seg); x.v4 = *(const LAS f32x4*)(rec + 128 + 4 * vg); x.gl = *(const LAS f32x2*)(rec + 144);
    }
    __device__ __forceinline__ void step(const In& x, int t) {
        const f32x4 q4 = x.q4, k4 = x.k4, v4 = x.v4; const f32x2 gl = x.gl;
        const float ig = gl[0], lf = gl[1];
        const float mn = fmaxf(lf + m, ig), wo = __expf(lf + m - mn), wi = __expf(ig - mn); m = mn;
        const f32x2 ka = {k4[0], k4[1]}, kb = {k4[2], k4[3]}, qa = {q4[0], q4[1]}, qb = {q4[2], q4[3]};
        nn[0] = wo * nn[0] + wi * ka; nn[1] = wo * nn[1] + wi * kb;
        const f32x2 dd = nn[0] * qa + nn[1] * qb; float den = red16(dd[0] + dd[1]);
        f32x4 num;
#pragma unroll
        for (int i = 0; i < 4; ++i) { const float wv = wi * v4[i]; C[i][0] = wo * C[i][0] + wv * ka; C[i][1] = wo * C[i][1] + wv * kb; const f32x2 nd = C[i][0] * qa + C[i][1] * qb; num[i] = red16(nd[0] + nd[1]); }
        const float inv = __builtin_amdgcn_rcpf(fmaxf(fabsf(den), __expf(-m)));
        const bool mine = seg == (t & (PB - 1));
        ko[0] = mine ? num[0] * inv : ko[0]; ko[1] = mine ? num[1] * inv : ko[1]; ko[2] = mine ? num[2] * inv : ko[2]; ko[3] = mine ? num[3] * inv : ko[3];
    }
    f32x4 ko;
    __device__ __forceinline__ void flush(int t0) { if (seg < PB) *(f32x4*)(ob + (size_t)(t0 + seg) * 1536) = ko; }
    __device__ __forceinline__ void finish(const P& p, int l, int b, int h, int unit) const {
        const size_t bh = ((size_t)l * 8 + b) * 4 + h;
        float* op = p.out + O_MC_P + bh * 8192 + (size_t)(u16 + vg * 4) * 64 + 4 * seg;
#pragma unroll
        for (int i = 0; i < 4; ++i) *(f32x4*)(op + i * 64) = (f32x4){C[i][0][0], C[i][0][1], C[i][1][0], C[i][1][1]};
        if (unit == 0 && vg == 0) { *(f32x4*)(p.out + O_MN_P + bh * 64 + 4 * seg) = (f32x4){nn[0][0], nn[0][1], nn[1][0], nn[1][1]}; if (seg == 0) p.out[O_MM_P + bh] = m; }
    }
};
template <class Sc> __device__ __forceinline__ void run_pscan(const P& p, int l, int b, int h, int unit, int lane, LAS float* wl) {
    Sc sc; sc.init(p, l, b, h, unit, lane);
    LAS float* slot0 = wl; LAS float* slot1 = wl + 4096;
    typename Sc::Stg s0, s1;
    sc.issue(0, s0); sc.issue(1, s1);
    sc.write(s0, slot0); sc.issue(2, s0);
    typename Sc::In cur, nxt;
    sc.load(slot0, cur);
#pragma unroll 1
    for (int i = 0; i < NPB; i += 2) {
        sc.write(s1, slot1); sc.issue(i + 3, s1);
#pragma unroll 4
        for (int tk = 0; tk < PB; ++tk) { sc.load(tk + 1 < PB ? slot0 + (tk + 1) * Sc::REC : slot1, nxt); sc.step(cur, tk); cur = nxt; }
        sc.flush(i * PB);
        sc.write(s0, slot0); sc.issue(i + 4, s0);
#pragma unroll 4
        for (int tk = 0; tk < PB; ++tk) { sc.load(tk + 1 < PB ? slot1 + (tk + 1) * Sc::REC : slot0, nxt); sc.step(cur, tk); cur = nxt; }
        sc.flush((i + 1) * PB);
    }
    sc.finish(p, l, b, h, unit);
}

__device__ void phase_scan(const P& p, int l, LAS unsigned char* lds) {
    const int lane = my_tid() & 63, wv = my_tid() >> 6; const int G = my_grid();
    if (wv < 4) {
        LAS float* wl = (LAS float*)(lds + wv * 32768);
        for (int blk = my_bid(); blk < 256; blk += G) {
            const int bh = blk >> 3, sub = blk & 7, b = bh >> 2, h = bh & 3;
            if (wv == 0) run_pscan<PScanA>(p, l, b, h, sub, lane, wl);
            else if (wv == 1) run_pscan<PScanB>(p, l, b, h, sub, lane, wl);
            else run_pscan<PScanC>(p, l, b, h, sub * 2 + (wv - 2), lane, wl);
        }
    } else {
        for (int su = my_bid() + G * (wv - 4); su < 6144; su += 4 * G) {
            const int br = su / 2048, idx = su % 2048, bh = idx >> 2, unit = idx & 3;
            if (br == 0) scanA<8>(p, l, 1, bh >> 2, bh & 3, unit, lane);
            else if (br == 1) scanB<8>(p, l, 1, bh >> 2, bh & 3, unit, lane);
            else scanC<8>(p, l, 1, bh >> 2, bh & 3, unit, lane);
        }
    }
}

__device__ void phase_norm(const P& p, int l) {
    const int lane = my_tid() & 63, wv = my_tid() >> 6, seg = lane & 15, hg = lane >> 4;
    const h16* proj = (const h16*)(p.ws + WS_P); const float* ob = (const float*)(p.ws + WS_R2); h16* ys = (h16*)(p.ws + WS_R1);
    for (int r = my_bid() + my_grid() * wv; r < T; r += my_grid() * NWAVES) {
#pragma unroll
        for (int it = 0; it < 3; ++it) {
            const int c = hg * 128 + seg * 8;
            const float* op = ob + (size_t)r * 1536 + it * 512 + c; const f32x4 o0 = *(const f32x4*)op, o1 = *(const f32x4*)(op + 4);
            float ss = 0.f;
#pragma unroll
            for (int j = 0; j < 4; ++j) ss += o0[j] * o0[j] + o1[j] * o1[j];
            ss = red16(ss); const float rs = rsqrtf(ss * (1.0f / 128.0f) + 1e-6f);
            const h16x8 gt = *(const h16x8*)(proj + (size_t)r * NPROJ + (it == 0 ? C_AG : (it == 1 ? C_BO : C_CG)) + c);
            const float* gp = p.in[it == 0 ? I_ANG : (it == 1 ? I_BNG : I_CNG)] + l * 512 + c; const f32x4 g0 = *(const f32x4*)gp, g1 = *(const f32x4*)(gp + 4);
            h16x8 y;
#pragma unroll
            for (int j = 0; j < 4; ++j) { y[j] = (h16)(o0[j] * rs * g0[j] * (float)gt[j]); y[4 + j] = (h16)(o1[j] * rs * g1[j] * (float)gt[4 + j]); }
            *(h16x8*)(ys + ((size_t)it * T + r) * 512 + c) = y;
        }
    }
}

__device__ void phase_ln(const P& p, const float* g, const float* bta, float* dst32) {
    const int lane = my_tid() & 63, wv = my_tid() >> 6;
    const float* pre = (const float*)(p.ws + WS_R2); h16* hh = (h16*)(p.ws + WS_R1);
    for (int r = my_bid() + my_grid() * wv; r < T; r += my_grid() * NWAVES) {
        f32x4 x[4]; float s = 0.f;
#pragma unroll
        for (int i = 0; i < 4; ++i) { x[i] = *(const f32x4*)(pre + (size_t)r * DM + 256 * i + 4 * lane); s += (x[i][0] + x[i][1]) + (x[i][2] + x[i][3]); }
        const float mu = red64(s) * (1.0f / DM); float q = 0.f;
#pragma unroll
        for (int i = 0; i < 4; ++i) { x[i] -= mu; q += (x[i][0] * x[i][0] + x[i][1] * x[i][1]) + (x[i][2] * x[i][2] + x[i][3] * x[i][3]); }
        const float rstd = rsqrtf(red64(q) * (1.0f / DM) + 1e-5f);
#pragma unroll
        for (int i = 0; i < 4; ++i) { const int c = 256 * i + 4 * lane; const f32x4 y = x[i] * rstd * *(const f32x4*)(g + c) + *(const f32x4*)(bta + c);
            *(f32x4*)(dst32 + (size_t)r * DM + c) = y; h16x4 o; o[0] = (h16)y[0]; o[1] = (h16)y[1]; o[2] = (h16)y[2]; o[3] = (h16)y[3]; *(h16x4*)(hh + (size_t)r * DM + c) = o; }
    }
}

#define XB_TMO      128
#define XB_XCNT(j)  (256  + 64 * (j))
#define XB_XSUB(j)  (1280 + 64 * (j))
#define XB_XGEN(j)  (2304 + 64 * (j))
#define XB_TOP      3328
#define XB_TOPGEN   3392
#define XCD_BAR_WORDS 3456
#define XB_SPIN_CAP (1u << 20)
__device__ __forceinline__ unsigned xb_ld(unsigned* p)              { return __hip_atomic_load(p, __ATOMIC_RELAXED, __HIP_MEMORY_SCOPE_AGENT); }
__device__ __forceinline__ unsigned xb_add(unsigned* p, unsigned v) { return __hip_atomic_fetch_add(p, v, __ATOMIC_RELAXED, __HIP_MEMORY_SCOPE_AGENT); }
__device__ __forceinline__ unsigned xb_xcc_id() { return (unsigned)__builtin_amdgcn_s_getreg((3 << 11) | 20) & 0xFu; }
#define XB_SPIN(cond, bar) do { unsigned _sp = 0; while (cond) { __builtin_amdgcn_s_sleep(1); \
    if ((++_sp & 255u) == 0u) { if (xb_ld(&(bar)[XB_TMO])) break; if (_sp > XB_SPIN_CAP) { atomicAdd(&(bar)[XB_TMO], 1u); break; } } } } while (0)
struct XcdBarrier { unsigned* bar; unsigned x; volatile LAS unsigned* st; };
__device__ __forceinline__ XcdBarrier xcd_barrier_post(unsigned* bar, volatile LAS unsigned* st) {
    XcdBarrier b; b.bar = bar; b.x = xb_xcc_id(); b.st = st;
    if (threadIdx.x == 0) (void)xb_add(&bar[XB_XCNT(b.x)], 1u);
    return b;
}
__device__ __forceinline__ void xcd_barrier_complete(unsigned* bar, unsigned x, unsigned& nloc, unsigned& nx) {
    const unsigned G = gridDim.x * gridDim.y * gridDim.z;
    unsigned sum, cnt, mine, sp = 0u;
    for (;;) {
        sum = 0u; cnt = 0u; mine = 0u;
#pragma unroll
        for (unsigned j = 0; j < 16; ++j) { const unsigned c = xb_ld(&bar[XB_XCNT(j)]); sum += c; cnt += (c > 0u) ? 1u : 0u; mine = (j == x) ? c : mine; }
        if (sum == G) break;
        __builtin_amdgcn_s_sleep(1);
        if ((++sp & 255u) == 0u) { if (xb_ld(&bar[XB_TMO])) break; if (sp > XB_SPIN_CAP) { atomicAdd(&bar[XB_TMO], 1u); break; } }
    }
    nloc = mine > 0u ? mine : 1u; nx = cnt > 0u ? cnt : 1u;
}
__device__ __forceinline__ void xcd_barrier(const XcdBarrier& b) {
    asm volatile("s_waitcnt vmcnt(0)" ::: "memory");
    __syncthreads();
    if (threadIdx.x == 0) {
        unsigned* bar = b.bar;
        __builtin_amdgcn_s_waitcnt(0);
        unsigned nloc = b.st[0], nx = b.st[1];
        if (nloc == 0u) { xcd_barrier_complete(bar, b.x, nloc, nx); b.st[0] = nloc; b.st[1] = nx; }
        const unsigned old = xb_add(&bar[XB_XSUB(b.x)], 1u);
        const unsigned gen = old / nloc;
        if (old + 1u == (gen + 1u) * nloc) {
            __builtin_amdgcn_fence(__ATOMIC_RELEASE, "agent");
            asm volatile("s_waitcnt vmcnt(0)" ::: "memory");
            const unsigned og = xb_add(&bar[XB_TOP], 1u);
            const unsigned tg = og / nx;
            if (og + 1u == (tg + 1u) * nx) xb_add(&bar[XB_TOPGEN], 1u);
            else XB_SPIN(xb_ld(&bar[XB_TOPGEN]) == tg, bar);
            __builtin_amdgcn_fence(__ATOMIC_ACQUIRE, "agent");
            xb_add(&bar[XB_XGEN(b.x)], 1u);
            asm volatile("s_waitcnt vmcnt(0)" ::: "memory");
        } else {
            XB_SPIN(xb_ld(&bar[XB_XGEN(b.x)]) == gen, bar);
            __builtin_amdgcn_fence(__ATOMIC_ACQUIRE, "agent");
            asm volatile("s_waitcnt vmcnt(0)" ::: "memory");
        }
    }
    __syncthreads();
}

#define PHASE_FN __device__ __forceinline__
PHASE_FN void ph_gemm_in(const P& p, int l, LAS unsigned char* lds) {
    unsigned char* ws = p.ws;
    pg8::Gemm g{(const h16*)(ws + WS_R1), (const h16*)(ws + WS_WIN) + (size_t)l * NPROJ * DM, T, NPROJ, DM}; pg8::StaticOrder S; S.init(T, NPROJ, my_grid(), my_bid());
    EpiIn E{(h16*)(ws + WS_P), (float*)(ws + WS_G), (const float*)(ws + WS_LB) + l * 512, p.in[I_BMI] + l * 4, p.in[I_BMF] + l * 4, p.in[I_ALOG] + l * 4, p.in[I_DTB] + l * 4};
    pg8::gemm_phase(lds, g, S, E);
}
PHASE_FN void ph_gemm_br(const P& p, int l, LAS unsigned char* lds) {
    unsigned char* ws = p.ws;
    pg8::Gemm g{(const h16*)(ws + WS_R1), (const h16*)(ws + WS_WBR) + (size_t)l * 3072 * 512, 3 * T, 3072, 512}; pg8::BranchOrder S{my_grid(), my_bid()};
    EpiBranch E{(const h16*)(ws + WS_P), (h16*)(ws + WS_R2 + (size_t)T * DM * 4)};
    pg8::gemm_phase(lds, g, S, E);
    tail_branch((const h16*)(ws + WS_R1), (const h16*)(ws + WS_WBR) + (size_t)l * 3072 * 512, (const h16*)(ws + WS_P), (h16*)(ws + WS_R2 + (size_t)T * DM * 4));
}
PHASE_FN void ph_gemm_out(const P& p, int l, LAS unsigned char* lds) {
    unsigned char* ws = p.ws;
    pg8::Gemm g{(const h16*)(ws + WS_R2 + (size_t)T * DM * 4), (const h16*)(ws + WS_WOUT) + (size_t)l * DM * DM, TP, DM, DM}; pg8::StaticOrder S; S.init(TP, DM, my_grid(), my_bid());
    EpiRes E{(const float*)(ws + WS_H32), (float*)(ws + WS_R2)};
    pg8::gemm_phase(lds, g, S, E);
    tail_res(g.A, DM, g.Bt, E.h32, E.pre32);
}
PHASE_FN void ph_gemm_f1(const P& p, int l, LAS unsigned char* lds) {
    unsigned char* ws = p.ws;
    pg8::Gemm g{(const h16*)(ws + WS_R1), (const h16*)(ws + WS_WF1) + (size_t)l * 2 * FFH * DM, T, 2 * FFH, DM}; pg8::StaticOrder S; S.init(T, 2 * FFH, my_grid(), my_bid());
    EpiSwiglu E{(h16*)(ws + WS_P)};
    pg8::gemm_phase(lds, g, S, E);
}
PHASE_FN void ph_gemm_f2(const P& p, int l, LAS unsigned char* lds) {
    unsigned char* ws = p.ws;
    pg8::Gemm g{(const h16*)(ws + WS_P), (const h16*)(ws + WS_WF2) + (size_t)l * DM * FFH, TP, DM, FFH}; pg8::StaticOrder S; S.init(TP, DM, my_grid(), my_bid());
    EpiRes E{(const float*)(ws + WS_H32), (float*)(ws + WS_R2)};
    pg8::gemm_phase(lds, g, S, E);
    tail_res(g.A, FFH, g.Bt, E.h32, E.pre32);
}
PHASE_FN void ph_prep(const P& p, LAS unsigned char* lds) { phase_prep(p, lds); }
PHASE_FN void ph_conv(const P& p, int l) { phase_conv(p, l); }
PHASE_FN void ph_scan(const P& p, int l, LAS unsigned char* lds) { phase_scan(p, l, lds); }
PHASE_FN void ph_norm(const P& p, int l) { phase_norm(p, l); }
PHASE_FN void ph_ln(const P& p, int l, int which) {
    float* h32 = (float*)(p.ws + WS_H32);
    if (which == 0) phase_ln(p, p.in[I_L1G] + l * DM, p.in[I_L1B] + l * DM, h32);
    else phase_ln(p, p.in[I_L2G] + l * DM, p.in[I_L2B] + l * DM, l == DEPTH - 1 ? p.out + O_Y : h32);
}

template <int MASK> __global__ void __launch_bounds__(NTHREADS, 2) fwd_kernel(P p) {
    extern __shared__ __attribute__((aligned(16))) unsigned char lds_raw[];
    LAS unsigned char* lds = (LAS unsigned char*)lds_raw;
    volatile LAS unsigned* bst = (volatile LAS unsigned*)(lds + pg8::STAGE_BYTES);
    if (threadIdx.x == 0) { bst[0] = 0u; bst[1] = 0u; }
    __syncthreads();
    XcdBarrier xbar; xbar.bar = (unsigned*)(p.ws + WS_BAR); xbar.x = 0; xbar.st = bst;
    if (p.hi - p.lo > 1) xbar = xcd_barrier_post((unsigned*)(p.ws + WS_BAR), bst);
#define GRID_SYNC(ph_) do { if ((ph_) == 0) cg::this_grid().sync(); else xcd_barrier(xbar); } while (0)
    for (int e = 0; e < EXTRA_SYNCS; ++e) xcd_barrier(xbar);
    for (int ph2 = 2 * p.lo; ph2 < 2 * p.hi; ++ph2) {
        const int ph = ph2 >> 1;
        if (ph2 & 1) { const int kb = ph == 0 ? 0 : 1 + (ph - 1) % 10; if (!((DUP_MASK >> kb) & 1)) { if (ph + 1 < p.hi) GRID_SYNC(ph); continue; } GRID_SYNC(ph); }
        if (ph == 0) { if constexpr ((MASK & 1) != 0) ph_prep(p, lds); }
        else {
            const int l = (ph - 1) / 10, k = (ph - 1) % 10;
            switch (k) {
            case 0: if constexpr ((MASK & 2) != 0) ph_gemm_in(p, l, lds); break;
            case 1: if constexpr ((MASK & 4) != 0) ph_conv(p, l); break;
            case 2: if constexpr ((MASK & 8) != 0) ph_scan(p, l, lds); break;
            case 3: if constexpr ((MASK & 16) != 0) ph_norm(p, l); break;
            case 4: if constexpr ((MASK & 32) != 0) ph_gemm_br(p, l, lds); break;
            case 5: if constexpr ((MASK & 64) != 0) ph_gemm_out(p, l, lds); break;
            case 6: if constexpr ((MASK & 128) != 0) ph_ln(p, l, 0); break;
            case 7: if constexpr ((MASK & 256) != 0) ph_gemm_f1(p, l, lds); break;
            case 8: if constexpr ((MASK & 512) != 0) ph_gemm_f2(p, l, lds); break;
            default: if constexpr ((MASK & 1024) != 0) ph_ln(p, l, 1); break;
            }
        }
        if ((ph2 & 1) && ph + 1 < p.hi) GRID_SYNC(ph);
    }
}

constexpr int N_PHASES = 1 + 10 * DEPTH;
constexpr int LDS_BYTES = pg8::STAGE_BYTES + 16;
constexpr int MASK_ALL = 2047;

template <int MASK> static bool setup_k() { return hipFuncSetAttribute((const void*)fwd_kernel<MASK>, hipFuncAttributeMaxDynamicSharedMemorySize, LDS_BYTES) == hipSuccess; }
template <int MASK> static void launch_k(int grid, hipStream_t stream, const P& p) { hipLaunchKernelGGL(fwd_kernel<MASK>, dim3(grid), dim3(NTHREADS), LDS_BYTES, stream, p); }

extern "C" void kernel_launch(void* const* d_in, const int* in_sizes, int n_in, void* d_out, int out_size, void* d_ws, size_t ws_size, hipStream_t stream) {
    static int grid = 0;
    if (grid == 0) {
        if (n_in != 26 || (size_t)out_size != O_END || ws_size < WS_END) { fprintf(stderr, "kernel_launch: unexpected sizes n_in %d out %d ws %zu (need %zu)\n", n_in, out_size, ws_size, (size_t)WS_END); grid = -1; return; }
        int dev = 0, cus = 0, per_cu = 0;
        (void)hipGetDevice(&dev); (void)hipDeviceGetAttribute(&cus, hipDeviceAttributeMultiprocessorCount, dev);
#if N_LAUNCH_MODE == 1
        bool ok = setup_k<MASK_ALL>();
        if (ok && (hipOccupancyMaxActiveBlocksPerMultiprocessor(&per_cu, (const void*)fwd_kernel<MASK_ALL>, NTHREADS, LDS_BYTES) != hipSuccess || per_cu < 1)) { fprintf(stderr, "occupancy query: %d\n", per_cu); }
#else
        bool ok = setup_k<1>() && setup_k<2>() && setup_k<4>() && setup_k<8>() && setup_k<16>() && setup_k<32>() && setup_k<64>() && setup_k<128>() && setup_k<256>() && setup_k<512>() && setup_k<1024>();
#endif
        if (!ok) { fprintf(stderr, "hipFuncSetAttribute failed\n"); grid = -1; return; }
        (void)hipGetLastError();
        grid = cus;
    }
    if (grid < 0) return;
    P p{};
    for (int i = 0; i < 26; ++i) p.in[i] = (const float*)d_in[i];
    p.out = (float*)d_out; p.ws = (unsigned char*)d_ws;
#if N_LAUNCH_MODE == 1
    if (hipMemsetAsync((unsigned char*)d_ws + WS_BAR, 0, XCD_BAR_WORDS * 4, stream) != hipSuccess) { fprintf(stderr, "memset of barrier words failed\n"); return; }
    p.lo = 0; p.hi = N_PHASES;
    void* args[] = {&p};
    hipError_t e = hipLaunchCooperativeKernel((const void*)fwd_kernel<MASK_ALL>, dim3(grid), dim3(NTHREADS), args, LDS_BYTES, stream);
    if (e != hipSuccess) fprintf(stderr, "cooperative launch failed: %s (grid %d)\n", hipGetErrorString(e), grid);
#else
    for (int ph = 0; ph < N_PHASES; ++ph) {
        p.lo = ph; p.hi = ph + 1;
        const int k = ph == 0 ? 0 : 1 + (ph - 1) % 10;
        switch (k) {
        case 0: launch_k<1>(grid, stream, p); break;
        case 1: launch_k<2>(grid, stream, p); break;
        case 2: launch_k<4>(grid, stream, p); break;
        case 3: launch_k<8>(grid, stream, p); break;
        case 4: launch_k<16>(grid, stream, p); break;
        case 5: launch_k<32>(grid, stream, p); break;
        case 6: launch_k<64>(grid, stream, p); break;
        case 7: launch_k<128>(grid, stream, p); break;
        case 8: launch_k<256>(grid, stream, p); break;
        case 9: launch_k<512>(grid, stream, p); break;
        default: launch_k<1024>(grid, stream, p); break;
        }
    }
#endif
}
```

```cpp
#include <hip/hip_runtime.h>
#include <hip/hip_cooperative_groups.h>
#include <cstdio>
namespace cg = cooperative_groups;

#ifndef N_LAUNCH_MODE
#define N_LAUNCH_MODE 1
#endif

#ifndef DUP_MASK
#define DUP_MASK 0
#endif
#ifndef EXTRA_SYNCS
#define EXTRA_SYNCS 0
#endif
#define LAS __attribute__((address_space(3)))
typedef _Float16 h16;
typedef _Float16 h16x8 __attribute__((ext_vector_type(8)));
typedef _Float16 h16x4 __attribute__((ext_vector_type(4)));
typedef _Float16 h16x2 __attribute__((ext_vector_type(2)));
typedef float f32x4 __attribute__((ext_vector_type(4)));
typedef float f32x2 __attribute__((ext_vector_type(2)));

constexpr int DM = 1024, TP = 16384, TS = 1024, T = TP + TS, DEPTH = 4;
constexpr int NSRC_IN = 8720, NPROJ = 8960, FFH = 2816;
constexpr int NTHREADS = 512, NWAVES = 8;
constexpr float ALPHA = 1.681792830507429f;
constexpr int C_AQ = 0, C_AF = 512, C_AI = 1024, C_AG = 1536, C_BQ = 2048, C_BK = 2304, C_BV = 2560, C_BO = 3072, C_CX = 3584, C_CG = 5120, C_MG = 5632, C_SM = 8704;

constexpr size_t SZ_WIN = (size_t)DEPTH * NPROJ * DM * 2, SZ_WBR = (size_t)DEPTH * 3072 * 512 * 2, SZ_WOUT = (size_t)DEPTH * DM * DM * 2,
                 SZ_WF1 = (size_t)DEPTH * 2 * FFH * DM * 2, SZ_WF2 = (size_t)DEPTH * DM * FFH * 2, SZ_LB = DEPTH * 512 * 4;
constexpr size_t WS_WIN = 0, WS_WBR = WS_WIN + SZ_WIN, WS_WOUT = WS_WBR + SZ_WBR, WS_WF1 = WS_WOUT + SZ_WOUT, WS_WF2 = WS_WF1 + SZ_WF1, WS_LB = WS_WF2 + SZ_WF2;
constexpr size_t WS_H32 = WS_LB + SZ_LB, WS_P = WS_H32 + (size_t)T * DM * 4, WS_G = WS_P + (size_t)T * NPROJ * 2, WS_R1 = WS_G + (size_t)T * 16 * 4,
                 WS_R2 = WS_R1 + (size_t)T * 1536 * 2, WS_BAR = WS_R2 + (size_t)T * 1536 * 4, WS_END = WS_BAR + 16384;
constexpr size_t O_Y = 0, O_HA_P = (size_t)T * DM, O_HA_S = O_HA_P + (size_t)DEPTH * 8 * 4 * 16384, O_MC_P = O_HA_S + (size_t)DEPTH * 128 * 4 * 16384,
                 O_MC_S = O_MC_P + (size_t)DEPTH * 8 * 4 * 8192, O_MN_P = O_MC_S + (size_t)DEPTH * 128 * 4 * 8192, O_MN_S = O_MN_P + DEPTH * 8 * 4 * 64,
                 O_MM_P = O_MN_S + DEPTH * 128 * 4 * 64, O_MM_S = O_MM_P + DEPTH * 8 * 4, O_G_P = O_MM_S + DEPTH * 128 * 4, O_G_S = O_G_P + (size_t)DEPTH * 8 * 4 * 16384,
                 O_CV_P = O_G_S + (size_t)DEPTH * 128 * 4 * 16384, O_CV_S = O_CV_P + (size_t)DEPTH * 8 * 3 * 1536, O_END = O_CV_S + (size_t)DEPTH * 128 * 3 * 1536;

struct P { const float* in[26]; float* out; unsigned char* ws; int lo, hi; };
enum { I_XP = 0, I_XS, I_SA, I_SC, I_SN, I_SM, I_SG, I_SV, I_WIN, I_LB, I_ANG, I_BMI, I_BMF, I_BNG, I_CW, I_ALOG, I_DTB, I_CNG, I_WBR, I_WOUT, I_L1G, I_L1B, I_WF1, I_WF2, I_L2G, I_L2B };

__device__ __forceinline__ int my_tid() { int t = threadIdx.x; asm volatile("" : "+v"(t)); return t; }
__device__ __forceinline__ int my_bid() { int b = blockIdx.x; asm volatile("" : "+s"(b)); return b; }
__device__ __forceinline__ int my_grid() { int g = gridDim.x; asm volatile("" : "+s"(g)); return g; }
__device__ __forceinline__ float sigm(float x) { return __builtin_amdgcn_rcpf(1.0f + __expf(-x)); }
__device__ __forceinline__ float silu(float x) { return x * sigm(x); }
template <int CTRL> __device__ __forceinline__ float dppf(float x) { return __builtin_bit_cast(float, __builtin_amdgcn_mov_dpp(__builtin_bit_cast(int, x), CTRL, 0xf, 0xf, true)); }
__device__ __forceinline__ float red16(float x) { x += dppf<0xB1>(x); x += dppf<0x4E>(x); x += dppf<0x124>(x); x += dppf<0x128>(x); return x; }
__device__ __forceinline__ float red64(float x) { x = red16(x); x += __shfl_xor(x, 16); x += __shfl_xor(x, 32); return x; }

namespace pg8 {
constexpr int BM = 256, BK = 64, HALF = 128, HTB = HALF * BK * 2, STAGE_BYTES = 8 * HTB, NXCD = 8, WGM = 8;
__device__ __forceinline__ int lds_byte(int r, int c) { const int st = (r >> 4) * 2 + (c >> 5), rr = r & 15, cc = c & 31, ob = rr * 64 + cc * 2; return st * 1024 + (ob ^ (((ob >> 9) & 1) << 5)); }
__device__ __forceinline__ void stage_rc(int b, int& R, int& C) { const int st = b / 1024, sb = b % 1024, swz = sb ^ (((sb >> 9) & 1) << 5); R = (st >> 1) * 16 + swz / 64; C = (st & 1) * 32 + (swz % 64) / 2; }
__device__ __forceinline__ int perm32(int rho) { const int n = rho >> 4, i = rho & 15; return 8 * (i >> 2) + 4 * n + (i & 3); }
struct Unit { int pm, pn; };
struct Gemm { const h16* A; const h16* Bt; int M, N, K; };
struct StaticOrder {
    int nM, nN, nwg, G, c;
    __device__ void init(int M, int N, int G_, int c_) { nM = M / BM; nN = N / BM; nwg = nM * nN; G = G_; c = c_; }
    __device__ bool next(int i, Unit& u) const {
        const long L = (long)i * G + c; if (L >= nwg) return false;
        int wgid = (int)L; { const int q = nwg / NXCD, r = nwg % NXCD, xcd = wgid % NXCD, off = wgid / NXCD; wgid = (xcd < r ? xcd * (q + 1) : r * (q + 1) + (xcd - r) * q) + off; }
        const int nig = WGM * nN, gid = wgid / nig, fm = gid * WGM, gsz = (nM - fm) < WGM ? (nM - fm) : WGM;
        u.pm = fm + ((wgid % nig) % gsz); u.pn = (wgid % nig) / gsz; return true;
    }
};
struct BranchOrder {
    int G, c;
    __device__ bool next(int i, Unit& u) const {
        const int ti = i / 3, br = i - 3 * ti; const int tile = ti * G + c; if (tile >= 64 * 4) return false;
        u.pm = (tile >> 2) + 68 * br; u.pn = (tile & 3) + 4 * br; return true;
    }
};

template <class Epi, class Sched>
__device__ __forceinline__ void gemm_phase(LAS unsigned char* lds, const Gemm g, const Sched& S, const Epi& E) {
    const int tid = my_tid(), wid = __builtin_amdgcn_readfirstlane(tid >> 6), lane = tid & 63, wr = wid >> 2, wc = wid & 3, fr = lane & 15, fq = lane >> 4;
    const int K = g.K, nt = K / BK;
    unsigned voffA[2], voffB[2];
#pragma unroll
    for (int i = 0; i < 2; ++i) { int R, C; stage_rc(tid * 16 + i * 8192, R, C); const int Rb = Epi::PERM ? ((R & ~31) + perm32(R & 31)) : R;
        voffA[i] = (unsigned)(R * K + C) * 2u; voffB[i] = (unsigned)(Rb * K + C) * 2u; }
    const size_t kstep = (size_t)(BK * 2);
    const size_t hstep = (size_t)HALF * K * 2;
    const size_t tstep = 2 * hstep;
    const unsigned ldsw = (unsigned)wid * 1024u;
    const int aoff = lds_byte(wr * 64 + fr, fq * 8), boff = lds_byte(wc * 32 + fr, fq * 8);
#define PG8_SA(b, h) (((b) * 2 + (h)) * HTB)
#define PG8_SB(b, h) ((4 + (b) * 2 + (h)) * HTB)
#define PG8_STAGE(bufoff, gbase, voff) do { _Pragma("unroll") for (int _i = 0; _i < 2; ++_i) \
        __builtin_amdgcn_global_load_lds((const unsigned*)((const char*)(gbase) + (voff)[_i]), (LAS unsigned*)(lds + (bufoff) + ldsw + _i * 8192), 16, 0, 0); } while (0)
#define PG8_LDA(dst, b, h) do { _Pragma("unroll") for (int m = 0; m < 4; ++m) _Pragma("unroll") for (int k = 0; k < 2; ++k) dst[m][k] = *(const LAS h16x8*)(lds + PG8_SA(b, h) + aoff + m * 2048 + k * 1024); } while (0)
#define PG8_LDB(dst, b, h) do { _Pragma("unroll") for (int n = 0; n < 2; ++n) _Pragma("unroll") for (int k = 0; k < 2; ++k) dst[n][k] = *(const LAS h16x8*)(lds + PG8_SB(b, h) + boff + n * 2048 + k * 1024); } while (0)
#define PG8_MMA(ai, bj, At, Bt) do { __builtin_amdgcn_s_setprio(1); _Pragma("unroll") for (int m = 0; m < 4; ++m) _Pragma("unroll") for (int n = 0; n < 2; ++n) _Pragma("unroll") for (int k = 0; k < 2; ++k) \
        acc[ai][bj][m][n] = __builtin_amdgcn_mfma_f32_16x16x32_f16(Bt[n][k], At[m][k], acc[ai][bj][m][n], 0, 0, 0); __builtin_amdgcn_s_setprio(0); } while (0)
#define PG8_WAIT_V(n) asm volatile("s_waitcnt vmcnt(" #n ")" ::: "memory")
#define PG8_WAIT_L(n) asm volatile("s_waitcnt lgkmcnt(" #n ")" ::: "memory")
#define PG8_BAR __builtin_amdgcn_s_barrier()
#define PG8_SCHED __builtin_amdgcn_sched_barrier(0)
    Unit cur, nxt; int ui = 0;
    if (!S.next(0, cur)) return;
    f32x4 acc[2][2][4][2];
#pragma unroll
    for (int a = 0; a < 2; ++a)
#pragma unroll
        for (int b = 0; b < 2; ++b)
#pragma unroll
            for (int m = 0; m < 4; ++m)
#pragma unroll
                for (int n = 0; n < 2; ++n) acc[a][b][m][n] = (f32x4){0.f, 0.f, 0.f, 0.f};
    h16x8 At[4][2], B0[2][2], B1[2][2];
    const char* cA = (const char*)g.A + (size_t)cur.pm * tstep; const char* cB = (const char*)g.Bt + (size_t)cur.pn * tstep;
    PG8_STAGE(PG8_SB(0, 0), cB, voffB); PG8_STAGE(PG8_SA(0, 0), cA, voffA); PG8_STAGE(PG8_SB(0, 1), cB + hstep, voffB); PG8_STAGE(PG8_SA(0, 1), cA + hstep, voffA);
    if (wr == 1) PG8_BAR;
    PG8_WAIT_V(4); PG8_BAR;
    PG8_STAGE(PG8_SB(1, 0), cB + kstep, voffB); PG8_STAGE(PG8_SA(1, 0), cA + kstep, voffA); PG8_STAGE(PG8_SB(1, 1), cB + hstep + kstep, voffB);
    PG8_WAIT_V(6); PG8_BAR;
    for (;;) {
        const bool has_next = S.next(ui + 1, nxt);
        const char* nA = has_next ? (const char*)g.A + (size_t)nxt.pm * tstep : cA; const char* nB = has_next ? (const char*)g.Bt + (size_t)nxt.pn * tstep : cB;
        for (int t = 0; t < nt; t += 2) {
            const bool last = (t == nt - 2);
            const char* a1 = cA + (size_t)(t + 1) * kstep;
            const char* a2 = last ? nA : cA + (size_t)(t + 2) * kstep; const char* b2 = last ? nB : cB + (size_t)(t + 2) * kstep;
            const char* a3 = a2 + kstep; const char* b3 = b2 + kstep;
            PG8_LDB(B0, 0, 0); PG8_SCHED; PG8_LDA(At, 0, 0); PG8_STAGE(PG8_SA(1, 1), a1 + hstep, voffA);
            PG8_WAIT_L(8); PG8_BAR; PG8_WAIT_L(0); PG8_MMA(0, 0, At, B0); PG8_BAR; PG8_SCHED;
            PG8_LDB(B1, 0, 1); PG8_STAGE(PG8_SB(0, 0), b2, voffB);
            PG8_BAR; PG8_WAIT_L(0); PG8_MMA(0, 1, At, B1); PG8_BAR;
            PG8_LDA(At, 0, 1); PG8_STAGE(PG8_SA(0, 0), a2, voffA);
            PG8_BAR; PG8_WAIT_L(0); PG8_MMA(1, 0, At, B0); PG8_BAR; PG8_SCHED;
            PG8_STAGE(PG8_SB(0, 1), b2 + hstep, voffB);
            PG8_WAIT_V(6); PG8_BAR; PG8_MMA(1, 1, At, B1); PG8_BAR;
            PG8_LDB(B0, 1, 0); PG8_SCHED; PG8_LDA(At, 1, 0); PG8_STAGE(PG8_SA(0, 1), a2 + hstep, voffA);
            PG8_WAIT_L(8); PG8_BAR; PG8_WAIT_L(0); PG8_MMA(0, 0, At, B0); PG8_BAR; PG8_SCHED;
            PG8_LDB(B1, 1, 1); PG8_STAGE(PG8_SB(1, 0), b3, voffB);
            PG8_BAR; PG8_WAIT_L(0); PG8_MMA(0, 1, At, B1); PG8_BAR;
            PG8_LDA(At, 1, 1); PG8_STAGE(PG8_SA(1, 0), a3, voffA);
            PG8_BAR; PG8_WAIT_L(0); PG8_MMA(1, 0, At, B0); PG8_BAR; PG8_SCHED;
            PG8_STAGE(PG8_SB(1, 1), b3 + hstep, voffB);
            PG8_WAIT_V(6); PG8_BAR; PG8_MMA(1, 1, At, B1); PG8_BAR;
        }
        E(acc, cur, wr, wc, fr, fq);
        if (!has_next) break;
        if constexpr (!Epi::KEEP_ACC) {
#pragma unroll
        for (int a = 0; a < 2; ++a)
#pragma unroll
            for (int b = 0; b < 2; ++b)
#pragma unroll
                for (int m = 0; m < 4; ++m)
#pragma unroll
                    for (int n = 0; n < 2; ++n) acc[a][b][m][n] = (f32x4){0.f, 0.f, 0.f, 0.f};
        }
        cur = nxt; cA = nA; cB = nB; ++ui;
    }
    PG8_WAIT_V(0);
    if (wr == 0) PG8_BAR;
    PG8_BAR;
#undef PG8_SA
#undef PG8_SB
#undef PG8_STAGE
#undef PG8_LDA
#undef PG8_LDB
#undef PG8_MMA
#undef PG8_WAIT_V
#undef PG8_WAIT_L
#undef PG8_BAR
#undef PG8_SCHED
}
}
using pg8::Unit;

__device__ __forceinline__ h16x8 pack8(const f32x4 a, const f32x4 b) {
    h16x8 o; o[0] = (h16)a[0]; o[1] = (h16)a[1]; o[2] = (h16)a[2]; o[3] = (h16)a[3]; o[4] = (h16)b[0]; o[5] = (h16)b[1]; o[6] = (h16)b[2]; o[7] = (h16)b[3]; return o;
}

struct EpiIn {
    static constexpr bool PERM = true, KEEP_ACC = false;
    h16* proj; float* gates; const float* lb; const float* b_mi; const float* b_mf; const float* a_log; const float* dt_bias;
    __device__ __forceinline__ void operator()(f32x4 (&acc)[2][2][4][2], const Unit& u, int wr, int wc, int fr, int fq) const {
        const int pn = u.pn; const int row0 = u.pm * 256 + wr * 64 + fr;
        if (pn == 34) {
            if (wc == 0 && fq < 2) {
                f32x4 c0, c1;
                if (fq == 0) { c0 = *(const f32x4*)b_mi; c1 = *(const f32x4*)b_mf; } else { c0 = *(const f32x4*)a_log; c1 = *(const f32x4*)dt_bias; }
#pragma unroll
                for (int ai = 0; ai < 2; ++ai)
#pragma unroll
                    for (int m = 0; m < 4; ++m) {
                        const f32x4 x0 = acc[ai][0][m][0], x1 = acc[ai][0][m][1]; f32x4 y0, y1;
#pragma unroll
                        for (int j = 0; j < 4; ++j) {
                            if (fq == 0) { y0[j] = x0[j] + c0[j]; const float z = x1[j] + c1[j]; y1[j] = fminf(z, 0.f) - log1pf(__expf(-fabsf(z))); }
                            else { y0[j] = sigm(x0[j]); const float z = x1[j] + c1[j]; y1[j] = -__expf(c0[j]) * (fmaxf(z, 0.f) + log1pf(__expf(-fabsf(z)))); }
                        }
                        float* gp = gates + (size_t)(row0 + ai * 128 + m * 16) * 16 + 8 * fq;
                        *(f32x4*)gp = y0; *(f32x4*)(gp + 4) = y1;
                    }
            }
            return;
        }
        int mode = 0;
        if (pn < 2) mode = 1; else if (pn < 4) mode = 3; else if (pn < 6) mode = 0; else if (pn < 8) mode = 1; else if (pn == 8) mode = 4; else if (pn < 12) mode = 0;
        else if (pn < 14) mode = 2; else if (pn < 20) mode = 0; else if (pn < 22) mode = 1; else mode = 2;
        const int col0 = pn * 256 + wc * 32 + 8 * fq;
        f32x4 lbv[2][2];
        if (mode == 3) {
#pragma unroll
            for (int bj = 0; bj < 2; ++bj)
#pragma unroll
                for (int n = 0; n < 2; ++n) lbv[bj][n] = 1.0f - *(const f32x4*)(lb + (col0 - C_AF) + bj * 128 + 4 * n);
        }
#pragma unroll
        for (int ai = 0; ai < 2; ++ai)
#pragma unroll
            for (int m = 0; m < 4; ++m) {
                h16* rowp = proj + (size_t)(row0 + ai * 128 + m * 16) * NPROJ + col0;
#pragma unroll
                for (int bj = 0; bj < 2; ++bj) {
                    f32x4 v[2] = {acc[ai][bj][m][0], acc[ai][bj][m][1]};
                    if (mode == 1) { for (int n = 0; n < 2; ++n) for (int j = 0; j < 4; ++j) v[n][j] = silu(v[n][j]); }
                    else if (mode == 2) { for (int n = 0; n < 2; ++n) for (int j = 0; j < 4; ++j) v[n][j] = fmaxf(sigm(v[n][j]), 6.2e-5f); }
                    else if (mode == 3) { for (int n = 0; n < 2; ++n) for (int j = 0; j < 4; ++j) v[n][j] = lbv[bj][n][j] * sigm(-v[n][j]); }
                    else if (mode == 4) { v[0] *= 0.125f; v[1] *= 0.125f; }
                    *(h16x8*)(rowp + bj * 128) = pack8(v[0], v[1]);
                }
            }
    }
};
struct EpiBranch {
    static constexpr bool PERM = true, KEEP_ACC = true;
    const h16* proj; h16* mrg16;
    __device__ __forceinline__ void operator()(f32x4 (&acc)[2][2][4][2], const Unit& u, int wr, int wc, int fr, int fq) const {
        const int br = u.pn >> 2; const int pn = u.pn & 3, pm = u.pm - 68 * br;
        const int row0 = pm * 256 + wr * 64 + fr, col0 = pn * 256 + wc * 32 + 8 * fq;
#pragma unroll
        for (int ai = 0; ai < 2; ++ai)
#pragma unroll
            for (int m = 0; m < 4; ++m) {
                const size_t row = (size_t)(row0 + ai * 128 + m * 16);
#pragma unroll
                for (int bj = 0; bj < 2; ++bj) {
                    const h16* gp = proj + row * NPROJ + C_MG + br * 1024 + col0 + bj * 128;
                    const h16x8 gc = *(const h16x8*)gp;
                    f32x4 v0 = acc[ai][bj][m][0], v1 = acc[ai][bj][m][1];
                    if (br < 2) {
                        const h16x8 gn = *(const h16x8*)(gp + 1024);
#pragma unroll
                        for (int j = 0; j < 4; ++j) { v0[j] *= (float)gc[j] * __builtin_amdgcn_rcpf((float)gn[j]); v1[j] *= (float)gc[4 + j] * __builtin_amdgcn_rcpf((float)gn[4 + j]); }
                        acc[ai][bj][m][0] = v0; acc[ai][bj][m][1] = v1;
                    } else {
#pragma unroll
                        for (int j = 0; j < 4; ++j) { v0[j] *= (float)gc[j]; v1[j] *= (float)gc[4 + j]; }
                        *(h16x8*)(mrg16 + row * DM + col0 + bj * 128) = pack8(v0, v1);
                        acc[ai][bj][m][0] = (f32x4){0.f, 0.f, 0.f, 0.f}; acc[ai][bj][m][1] = (f32x4){0.f, 0.f, 0.f, 0.f};
                    }
                }
            }
    }
};
struct EpiRes {
    static constexpr bool PERM = false, KEEP_ACC = false;
    const float* h32; float* pre32;
    __device__ __forceinline__ void operator()(f32x4 (&acc)[2][2][4][2], const Unit& u, int wr, int wc, int fr, int fq) const {
        const int row0 = u.pm * 256 + wr * 64 + fr, col0 = u.pn * 256 + wc * 32 + 4 * fq;
#pragma unroll
        for (int ai = 0; ai < 2; ++ai)
#pragma unroll
            for (int m = 0; m < 4; ++m) {
                const size_t off = (size_t)(row0 + ai * 128 + m * 16) * DM + col0;
#pragma unroll
                for (int bj = 0; bj < 2; ++bj)
#pragma unroll
                    for (int n = 0; n < 2; ++n) { const f32x4 hv = *(const f32x4*)(h32 + off + bj * 128 + n * 16); *(f32x4*)(pre32 + off + bj * 128 + n * 16) = ALPHA * hv + acc[ai][bj][m][n]; }
            }
    }
};
struct EpiSwiglu {
    static constexpr bool PERM = true, KEEP_ACC = false;
    h16* ff;
    __device__ __forceinline__ void operator()(f32x4 (&acc)[2][2][4][2], const Unit& u, int wr, int wc, int fr, int fq) const {
        const int row0 = u.pm * 256 + wr * 64 + fr, col0 = u.pn * 128 + wc * 32 + 8 * fq;
#pragma unroll
        for (int ai = 0; ai < 2; ++ai)
#pragma unroll
            for (int m = 0; m < 4; ++m) {
                f32x4 v[2];
#pragma unroll
                for (int n = 0; n < 2; ++n)
#pragma unroll
                    for (int j = 0; j < 4; ++j) v[n][j] = silu(acc[ai][0][m][n][j]) * acc[ai][1][m][n][j];
                *(h16x8*)(ff + (size_t)(row0 + ai * 128 + m * 16) * FFH + col0) = pack8(v[0], v[1]);
            }
    }
};

__device__ __forceinline__ void tail_kloop(const h16* __restrict__ ap, const h16* __restrict__ b0p, const h16* __restrict__ b1p, int K, f32x4& c0, f32x4& c1) {
#pragma unroll 8
    for (int k = 0; k < K; k += 32) {
        const h16x8 a = *(const h16x8*)(ap + k), b0 = *(const h16x8*)(b0p + k), b1 = *(const h16x8*)(b1p + k);
        c0 = __builtin_amdgcn_mfma_f32_16x16x32_f16(b0, a, c0, 0, 0, 0); c1 = __builtin_amdgcn_mfma_f32_16x16x32_f16(b1, a, c1, 0, 0, 0);
    }
}
__device__ void tail_res(const h16* A, int K, const h16* Bt, const float* h32, float* pre32) {
    const int tid = my_tid(), w = tid >> 6, lane = tid & 63, fr = lane & 15, fq = lane >> 4;
    for (int tile = my_bid(); tile < 256; tile += my_grid()) {
        const int row = TP + (tile >> 4) * 64 + (w >> 1) * 16 + fr, col0 = (tile & 15) * 64 + (w & 1) * 32;
        f32x4 c0 = {0.f, 0.f, 0.f, 0.f}, c1 = {0.f, 0.f, 0.f, 0.f};
        tail_kloop(A + (size_t)row * K + fq * 8, Bt + (size_t)(col0 + fr) * K + fq * 8, Bt + (size_t)(col0 + 16 + fr) * K + fq * 8, K, c0, c1);
        const size_t off = (size_t)row * DM + col0 + 4 * fq;
        *(f32x4*)(pre32 + off) = ALPHA * *(const f32x4*)(h32 + off) + c0; *(f32x4*)(pre32 + off + 16) = ALPHA * *(const f32x4*)(h32 + off + 16) + c1;
    }
}
__device__ void tail_branch(const h16* ys, const h16* Wbr, const h16* proj, h16* mrg16) {
    const int tid = my_tid(), w = tid >> 6, lane = tid & 63, fr = lane & 15, fq = lane >> 4;
    for (int tile = my_bid(); tile < 256; tile += my_grid()) {
        const int row = TP + (tile >> 4) * 64 + (w >> 1) * 16 + fr, col0 = (tile & 15) * 64 + (w & 1) * 32;
        f32x4 m0 = {0.f, 0.f, 0.f, 0.f}, m1 = {0.f, 0.f, 0.f, 0.f};
#pragma unroll 1
        for (int br = 0; br < 3; ++br) {
            f32x4 c0 = {0.f, 0.f, 0.f, 0.f}, c1 = {0.f, 0.f, 0.f, 0.f};
            const h16* Bt = Wbr + (size_t)br * 1024 * 512;
            tail_kloop(ys + ((size_t)br * T + row) * 512 + fq * 8, Bt + (size_t)(col0 + fr) * 512 + fq * 8, Bt + (size_t)(col0 + 16 + fr) * 512 + fq * 8, 512, c0, c1);
            const h16* gp = proj + (size_t)row * NPROJ + C_MG + br * 1024 + col0 + 4 * fq; const h16x4 g0 = *(const h16x4*)gp, g1 = *(const h16x4*)(gp + 16);
#pragma unroll
            for (int j = 0; j < 4; ++j) { m0[j] += (float)g0[j] * c0[j]; m1[j] += (float)g1[j] * c1[j]; }
        }
        h16x4 o0, o1;
#pragma unroll
        for (int j = 0; j < 4; ++j) { o0[j] = (h16)m0[j]; o1[j] = (h16)m1[j]; }
        h16* op = mrg16 + (size_t)row * DM + col0 + 4 * fq; *(h16x4*)op = o0; *(h16x4*)(op + 16) = o1;
    }
}

__device__ __forceinline__ int map_in(int n) {
    if (n < 3584) return n;
    if (n < 5632) return n + 8;
    if (n < 8704) return n + 16;
    if (n < 8708) return 3584 + (n - 8704);
    if (n < 8712) return 3588 + (n - 8708);
    if (n < 8716) return 5640 + (n - 8712);
    if (n < 8720) return 5644 + (n - 8716);
    return -1;
}
__device__ __forceinline__ int map_f1(int n) { const int p = n >> 8, w = n & 255; return w < 128 ? 128 * p + w : FFH + 128 * p + (w - 128); }
__device__ __forceinline__ void tr_tile(const float* __restrict__ src, int Nsrc, h16* __restrict__ dst, int K, int n0, int k0, int mapid, LAS float* tile) {
    const int tid = my_tid(), tx = tid & 31, ty = tid >> 5;
    const int n = n0 + 4 * tx; const int sc = mapid == 0 ? n : (mapid == 1 ? map_in(n) : map_f1(n));
#pragma unroll
    for (int p = 0; p < 4; ++p) { const int k = ty + 16 * p; const f32x4 v = sc >= 0 ? *(const f32x4*)(src + (size_t)(k0 + k) * Nsrc + sc) : (f32x4){0.f, 0.f, 0.f, 0.f};
#pragma unroll
        for (int j = 0; j < 4; ++j) tile[(4 * tx + j) * 68 + k] = v[j]; }
    __syncthreads();
    const int nn = tid >> 2, ks = (tid & 3) * 16;
    const LAS float* tp = tile + nn * 68 + ks;
    const f32x4 a0 = *(const LAS f32x4*)tp, a1 = *(const LAS f32x4*)(tp + 4), a2 = *(const LAS f32x4*)(tp + 8), a3 = *(const LAS f32x4*)(tp + 12);
    h16* dp = dst + (size_t)(n0 + nn) * K + k0 + ks;
    *(h16x8*)dp = pack8(a0, a1); *(h16x8*)(dp + 8) = pack8(a2, a3);
    __syncthreads();
}
__device__ void phase_prep(const P& p, LAS unsigned char* lds) {
    LAS float* tile = (LAS float*)lds;
    unsigned char* ws = p.ws;
    constexpr int T_IN = (NPROJ / 128) * (DM / 64), T_BR = 3 * (1024 / 128) * (512 / 64), T_OUT = 8 * 16, T_F1 = (2 * FFH / 128) * 16, T_F2 = 8 * (FFH / 64), T_L = T_IN + T_BR + T_OUT + T_F1 + T_F2;
    for (int id = my_bid(); id < DEPTH * T_L; id += my_grid()) {
        const int l = id / T_L; int r = id - l * T_L;
        if (r < T_IN) { const int tn = r / 16, tk = r % 16; tr_tile(p.in[I_WIN] + (size_t)l * DM * NSRC_IN, NSRC_IN, (h16*)(ws + WS_WIN) + (size_t)l * NPROJ * DM, DM, tn * 128, tk * 64, 1, tile); continue; }
        r -= T_IN;
        if (r < T_BR) { const int br = r / 64, q = r % 64, tn = q / 8, tk = q % 8; tr_tile(p.in[I_WBR] + ((size_t)l * 3 + br) * 512 * 1024, 1024, (h16*)(ws + WS_WBR) + ((size_t)l * 3 + br) * 1024 * 512, 512, tn * 128, tk * 64, 0, tile); continue; }
        r -= T_BR;
        if (r < T_OUT) { const int tn = r / 16, tk = r % 16; tr_tile(p.in[I_WOUT] + (size_t)l * DM * DM, DM, (h16*)(ws + WS_WOUT) + (size_t)l * DM * DM, DM, tn * 128, tk * 64, 0, tile); continue; }
        r -= T_OUT;
        if (r < T_F1) { const int tn = r / 16, tk = r % 16; tr_tile(p.in[I_WF1] + (size_t)l * DM * 2 * FFH, 2 * FFH, (h16*)(ws + WS_WF1) + (size_t)l * 2 * FFH * DM, DM, tn * 128, tk * 64, 2, tile); continue; }
        r -= T_F1;
        { const int tn = r / (FFH / 64), tk = r % (FFH / 64); tr_tile(p.in[I_WF2] + (size_t)l * FFH * DM, DM, (h16*)(ws + WS_WF2) + (size_t)l * DM * FFH, FFH, tn * 128, tk * 64, 0, tile); }
    }
    if (my_bid() == 0) {
        const int c = my_tid(); const float* lg = p.in[I_LB];
        const float a0 = lg[c], a1 = lg[512 + c], a2 = lg[1024 + c], a3 = lg[1536 + c]; const float mx = fmaxf(fmaxf(a0, a1), fmaxf(a2, a3));
        const float e0 = expf(a0 - mx), e1 = expf(a1 - mx), e2 = expf(a2 - mx), e3 = expf(a3 - mx), inv = 1.0f / (e0 + e1 + e2 + e3);
        float* lb = (float*)(ws + WS_LB); lb[c] = 0.f; lb[512 + c] = e1 * inv; lb[1024 + c] = (e1 + e2) * inv; lb[1536 + c] = (e1 + e2 + e3) * inv;
    }
    float* h32 = (float*)(ws + WS_H32); h16* hh = (h16*)(ws + WS_R1);
    const size_t n4 = (size_t)T * DM / 4, np4 = (size_t)TP * DM / 4;
    for (size_t i = (size_t)my_bid() * NTHREADS + my_tid(); i < n4; i += (size_t)my_grid() * NTHREADS) {
        const f32x4 v = i < np4 ? ((const f32x4*)p.in[I_XP])[i] : ((const f32x4*)p.in[I_XS])[i - np4];
        ((f32x4*)h32)[i] = v; h16x4 o; o[0] = (h16)v[0]; o[1] = (h16)v[1]; o[2] = (h16)v[2]; o[3] = (h16)v[3]; ((h16x4*)hh)[i] = o;
    }
}

__device__ void phase_conv(const P& p, int l) {
    const int lane = my_tid() & 63, wv = my_tid() >> 6, seg = lane & 15, hg = lane >> 4;
    const h16* proj = (const h16*)(p.ws + WS_P); h16* cprep = (h16*)(p.ws + WS_R1);
    const float* cw = p.in[I_CW] + (size_t)l * 4 * 1536;
    for (int r = my_bid() + my_grid() * wv; r < T; r += my_grid() * NWAVES) {
        int b, pos, L, grp; if (r < TP) { grp = 0; b = r >> 11; pos = r & 2047; L = 2048; } else { grp = 1; b = (r - TP) >> 3; pos = (r - TP) & 7; L = 8; }
#pragma unroll 1
        for (int it = 0; it < 3; ++it) {
            const int c = it * 512 + hg * 128 + seg * 8;
            float a[8];
#pragma unroll
            for (int j = 0; j < 8; ++j) a[j] = 0.f;
            h16x8 xc;
#pragma unroll
            for (int d = 0; d < 4; ++d) {
                float xv[8]; bool have = true;
                if (pos - d >= 0) { const h16x8 x = *(const h16x8*)(proj + (size_t)(r - d) * NPROJ + C_CX + c); if (d == 0) xc = x;
#pragma unroll
                    for (int j = 0; j < 8; ++j) xv[j] = (float)x[j]; }
                else if (grp) { const float* sp = p.in[I_SV] + (((size_t)l * 128 + b) * 3 + (3 + pos - d)) * 1536 + c; const f32x4 s0 = *(const f32x4*)sp, s1 = *(const f32x4*)(sp + 4);
#pragma unroll
                    for (int j = 0; j < 4; ++j) { xv[j] = s0[j]; xv[4 + j] = s1[j]; } }
                else have = false;
                if (have) { const f32x4 w0 = *(const f32x4*)(cw + (3 - d) * 1536 + c), w1 = *(const f32x4*)(cw + (3 - d) * 1536 + c + 4);
#pragma unroll
                    for (int j = 0; j < 4; ++j) { a[j] += xv[j] * w0[j]; a[4 + j] += xv[4 + j] * w1[j]; } }
            }
            float ss = 0.f;
#pragma unroll
            for (int j = 0; j < 8; ++j) { a[j] = silu(a[j]); ss += a[j] * a[j]; }
            if (it < 2) { ss = red16(ss); const float sc = rsqrtf(ss + 1e-6f) * (it == 0 ? 0.08838834764831845f : 1.0f);
#pragma unroll
                for (int j = 0; j < 8; ++j) a[j] *= sc; }
            h16x8 o;
#pragma unroll
            for (int j = 0; j < 8; ++j) o[j] = (h16)a[j];
            *(h16x8*)(cprep + (size_t)r * 1536 + c) = o;
            if (pos >= L - 3) {
                float* op = p.out + (grp ? O_CV_S + (((size_t)l * 128 + b) * 3 + (pos - (L - 3))) * 1536 : O_CV_P + (((size_t)l * 8 + b) * 3 + (pos - (L - 3))) * 1536) + c;
                f32x4 o0, o1;
#pragma unroll
                for (int j = 0; j < 4; ++j) { o0[j] = (float)xc[j]; o1[j] = (float)xc[4 + j]; }
                *(f32x4*)op = o0; *(f32x4*)(op + 4) = o1;
            }
        }
    }
}

template <int NC> __device__ __forceinline__ void ld_h(const h16* p, float (&v)[NC]) {
    if constexpr (NC == 2) { const h16x2 x = *(const h16x2*)p; v[0] = (float)x[0]; v[1] = (float)x[1]; }
    else { const h16x8 x = *(const h16x8*)p;
#pragma unroll
        for (int j = 0; j < 8; ++j) v[j] = (float)x[j]; }
}
template <int NC> __device__ __forceinline__ void st_f(float* p, const float (&v)[NC]) {
    if constexpr (NC == 2) { *(f32x2*)p = (f32x2){v[0], v[1]}; }
    else { *(f32x4*)p = (f32x4){v[0], v[1], v[2], v[3]}; *(f32x4*)(p + 4) = (f32x4){v[4], v[5], v[6], v[7]}; }
}
template <int NC> __device__ __forceinline__ void ld_f(const float* p, float (&v)[NC]) {
    if constexpr (NC == 2) { const f32x2 x = *(const f32x2*)p; v[0] = x[0]; v[1] = x[1]; }
    else { const f32x4 x = *(const f32x4*)p, y = *(const f32x4*)(p + 4);
#pragma unroll
        for (int j = 0; j < 4; ++j) { v[j] = x[j]; v[4 + j] = y[j]; } }
}

template <int NC> __device__ void scanA(const P& p, int l, int grp, int b, int h, int unit, int lane) {
    const int seg = lane & 15, cgp = lane >> 4; const int L = grp ? 8 : 2048; const size_t row0 = grp ? (size_t)TP + b * 8 : (size_t)b * 2048;
    const int c0 = unit * (4 * NC) + cgp * NC;
    float S[8][NC];
    const size_t sidx = (size_t)h * 16384 + (size_t)(8 * seg) * 128 + c0;
    if (grp) { const float* sp = p.in[I_SA] + ((size_t)l * 128 + b) * 65536 + sidx;
#pragma unroll
        for (int r = 0; r < 8; ++r) ld_f<NC>(sp + r * 128, S[r]); }
    else {
#pragma unroll
        for (int r = 0; r < 8; ++r)
#pragma unroll
            for (int j = 0; j < NC; ++j) S[r][j] = 0.f; }
    const h16* base = (const h16*)(p.ws + WS_P) + row0 * NPROJ + h * 128;
    float* ob = (float*)(p.ws + WS_R2) + row0 * 1536 + h * 128 + c0;
    h16x8 qn = *(const h16x8*)(base + C_AQ + 8 * seg), kn = *(const h16x8*)(base + C_AF + 8 * seg); float vn[NC]; ld_h<NC>(base + C_AI + c0, vn);
#pragma unroll 1
    for (int t = 0; t < L; ++t) {
        const h16x8 q8 = qn, k8 = kn; float v[NC];
#pragma unroll
        for (int j = 0; j < NC; ++j) v[j] = vn[j];
        if (t + 1 < L) { const h16* nb = base + (size_t)(t + 1) * NPROJ; qn = *(const h16x8*)(nb + C_AQ + 8 * seg); kn = *(const h16x8*)(nb + C_AF + 8 * seg); ld_h<NC>(nb + C_AI + c0, vn); }
        float o[NC];
#pragma unroll
        for (int j = 0; j < NC; ++j) o[j] = 0.f;
#pragma unroll
        for (int r = 0; r < 8; ++r) { const float kk = (float)k8[r], qq = (float)q8[r];
#pragma unroll
            for (int j = 0; j < NC; ++j) { S[r][j] += kk * (v[j] - S[r][j]); o[j] += S[r][j] * qq; } }
#pragma unroll
        for (int j = 0; j < NC; ++j) o[j] = red16(o[j]);
        if (seg == 0) st_f<NC>(ob + (size_t)t * 1536, o);
    }
    float* op = p.out + (grp ? O_HA_S + ((size_t)l * 128 + b) * 65536 : O_HA_P + ((size_t)l * 8 + b) * 65536) + sidx;
#pragma unroll
    for (int r = 0; r < 8; ++r) st_f<NC>(op + r * 128, S[r]);
}
template <int NC> __device__ void scanC(const P& p, int l, int grp, int b, int h, int unit, int lane) {
    const int seg = lane & 15, cgp = lane >> 4; const int L = grp ? 8 : 2048; const size_t row0 = grp ? (size_t)TP + b * 8 : (size_t)b * 2048;
    const int c0 = unit * (4 * NC) + cgp * NC;
    float S[8][NC];
    const size_t sidx = (size_t)h * 16384 + (size_t)(8 * seg) * 128 + c0;
    if (grp) { const float* sp = p.in[I_SG] + ((size_t)l * 128 + b) * 65536 + sidx;
#pragma unroll
        for (int r = 0; r < 8; ++r) ld_f<NC>(sp + r * 128, S[r]); }
    else {
#pragma unroll
        for (int r = 0; r < 8; ++r)
#pragma unroll
            for (int j = 0; j < NC; ++j) S[r][j] = 0.f; }
    const h16* base = (const h16*)(p.ws + WS_R1) + row0 * 1536 + h * 128;
    const float* gt = (const float*)(p.ws + WS_G) + row0 * 16 + h;
    float* ob = (float*)(p.ws + WS_R2) + row0 * 1536 + 1024 + h * 128 + c0;
    h16x8 qn = *(const h16x8*)(base + 8 * seg), kn = *(const h16x8*)(base + 512 + 8 * seg); float vn[NC]; ld_h<NC>(base + 1024 + c0, vn);
    float betan = gt[8], gn = gt[12];
#pragma unroll 1
    for (int t = 0; t < L; ++t) {
        const h16x8 q8 = qn, k8 = kn; float v[NC]; const float beta = betan, a = __expf(gn);
#pragma unroll
        for (int j = 0; j < NC; ++j) v[j] = vn[j];
        if (t + 1 < L) { const h16* nb = base + (size_t)(t + 1) * 1536; qn = *(const h16x8*)(nb + 8 * seg); kn = *(const h16x8*)(nb + 512 + 8 * seg); ld_h<NC>(nb + 1024 + c0, vn);
            betan = gt[(size_t)(t + 1) * 16 + 8]; gn = gt[(size_t)(t + 1) * 16 + 12]; }
        float kf[8], qf[8];
#pragma unroll
        for (int r = 0; r < 8; ++r) { kf[r] = (float)k8[r]; qf[r] = (float)q8[r]; }
        float u[NC];
#pragma unroll
        for (int j = 0; j < NC; ++j) u[j] = 0.f;
#pragma unroll
        for (int r = 0; r < 8; ++r)
#pragma unroll
            for (int j = 0; j < NC; ++j) u[j] += S[r][j] * kf[r];
        float o[NC];
#pragma unroll
        for (int j = 0; j < NC; ++j) { u[j] = red16(u[j]); u[j] = beta * (v[j] - a * u[j]); o[j] = 0.f; }
#pragma unroll
        for (int r = 0; r < 8; ++r)
#pragma unroll
            for (int j = 0; j < NC; ++j) { S[r][j] = a * S[r][j] + kf[r] * u[j]; o[j] += S[r][j] * qf[r]; }
#pragma unroll
        for (int j = 0; j < NC; ++j) o[j] = red16(o[j]);
        if (seg == 0) st_f<NC>(ob + (size_t)t * 1536, o);
    }
    float* op = p.out + (grp ? O_G_S + ((size_t)l * 128 + b) * 65536 : O_G_P + ((size_t)l * 8 + b) * 65536) + sidx;
#pragma unroll
    for (int r = 0; r < 8; ++r) st_f<NC>(op + r * 128, S[r]);
}
template <int NV> __device__ void scanB(const P& p, int l, int grp, int b, int h, int unit, int lane) {
    const int seg = lane & 15, vg = lane >> 4; const int L = grp ? 8 : 2048; const size_t row0 = grp ? (size_t)TP + b * 8 : (size_t)b * 2048;
    const int v0 = unit * (4 * NV) + vg * NV;
    float C[NV][4], nn[4], m;
    const size_t cidx = (size_t)h * 8192 + (size_t)v0 * 64 + 4 * seg;
    if (grp) { const float* sp = p.in[I_SC] + ((size_t)l * 128 + b) * 32768 + cidx;
#pragma unroll
        for (int i = 0; i < NV; ++i) { const f32x4 x = *(const f32x4*)(sp + i * 64); C[i][0] = x[0]; C[i][1] = x[1]; C[i][2] = x[2]; C[i][3] = x[3]; }
        const f32x4 x = *(const f32x4*)(p.in[I_SN] + (((size_t)l * 128 + b) * 4 + h) * 64 + 4 * seg); nn[0] = x[0]; nn[1] = x[1]; nn[2] = x[2]; nn[3] = x[3];
        m = p.in[I_SM][((size_t)l * 128 + b) * 4 + h]; }
    else {
#pragma unroll
        for (int i = 0; i < NV; ++i) { C[i][0] = 0.f; C[i][1] = 0.f; C[i][2] = 0.f; C[i][3] = 0.f; }
        nn[0] = nn[1] = nn[2] = nn[3] = 0.f; m = 0.f; }
    const h16* base = (const h16*)(p.ws + WS_P) + row0 * NPROJ;
    const float* gt = (const float*)(p.ws + WS_G) + row0 * 16 + h;
    float* ob = (float*)(p.ws + WS_R2) + row0 * 1536 + 512 + h * 128 + v0;
    h16x4 qn = *(const h16x4*)(base + C_BQ + h * 64 + 4 * seg), kn = *(const h16x4*)(base + C_BK + h * 64 + 4 * seg); float vn[NV]; ld_h<NV>(base + C_BV + h * 128 + v0, vn);
    float ign = gt[0], lfn = gt[4];
#pragma unroll 1
    for (int t = 0; t < L; ++t) {
        const h16x4 q4 = qn, k4 = kn; float v[NV]; const float ig = ign, lf = lfn;
#pragma unroll
        for (int i = 0; i < NV; ++i) v[i] = vn[i];
        if (t + 1 < L) { const h16* nb = base + (size_t)(t + 1) * NPROJ; qn = *(const h16x4*)(nb + C_BQ + h * 64 + 4 * seg); kn = *(const h16x4*)(nb + C_BK + h * 64 + 4 * seg); ld_h<NV>(nb + C_BV + h * 128 + v0, vn);
            ign = gt[(size_t)(t + 1) * 16]; lfn = gt[(size_t)(t + 1) * 16 + 4]; }
        const float mn = fmaxf(lf + m, ig), wo = __expf(lf + m - mn), wi = __expf(ig - mn); m = mn;
        float kf[4], qf[4];
#pragma unroll
        for (int r = 0; r < 4; ++r) { kf[r] = (float)k4[r]; qf[r] = (float)q4[r]; }
        float den = 0.f;
#pragma unroll
        for (int r = 0; r < 4; ++r) { nn[r] = wo * nn[r] + wi * kf[r]; den += nn[r] * qf[r]; }
        float num[NV];
#pragma unroll
        for (int i = 0; i < NV; ++i) { const float wv = wi * v[i]; num[i] = 0.f;
#pragma unroll
            for (int r = 0; r < 4; ++r) { C[i][r] = wo * C[i][r] + wv * kf[r]; num[i] += C[i][r] * qf[r]; } }
        den = red16(den);
        const float inv = 1.0f / fmaxf(fabsf(den), __expf(-m));
#pragma unroll
        for (int i = 0; i < NV; ++i) num[i] = red16(num[i]) * inv;
        if (seg == 0) st_f<NV>(ob + (size_t)t * 1536, num);
    }
    float* op = p.out + (grp ? O_MC_S + ((size_t)l * 128 + b) * 32768 : O_MC_P + ((size_t)l * 8 + b) * 32768) + cidx;
#pragma unroll
    for (int i = 0; i < NV; ++i) *(f32x4*)(op + i * 64) = (f32x4){C[i][0], C[i][1], C[i][2], C[i][3]};
    if (unit == 0 && vg == 0) {
        const size_t bh = grp ? ((size_t)l * 128 + b) * 4 + h : ((size_t)l * 8 + b) * 4 + h;
        *(f32x4*)(p.out + (grp ? O_MN_S : O_MN_P) + bh * 64 + 4 * seg) = (f32x4){nn[0], nn[1], nn[2], nn[3]};
        if (seg == 0) p.out[(grp ? O_MM_S : O_MM_P) + bh] = m;
    }
}
__device__ __forceinline__ void cvt8(const h16x8 x, LAS float* d) {
    *(LAS f32x4*)d = (f32x4){(float)x[0], (float)x[1], (float)x[2], (float)x[3]}; *(LAS f32x4*)(d + 4) = (f32x4){(float)x[4], (float)x[5], (float)x[6], (float)x[7]};
}
constexpr int PB = 8, NPB = 2048 / PB;
struct PScanA {
    static constexpr int REC = 272;
    struct Stg { h16x8 q[2], k[2], v; };
    const h16* base; int lane, seg, cgp; f32x2 S[8][2]; float* ob;
    __device__ __forceinline__ void init(const P& p, int l, int b, int h, int unit, int lane_) {
        lane = lane_; seg = lane & 15; cgp = lane >> 4;
        base = (const h16*)(p.ws + WS_P) + (size_t)b * 2048 * NPROJ + h * 128; ob = (float*)(p.ws + WS_R2) + (size_t)b * 2048 * 1536 + h * 128 + unit * 16 + cgp * 4;
        base += unit * 16;
#pragma unroll
        for (int r = 0; r < 8; ++r) { S[r][0] = (f32x2){0.f, 0.f}; S[r][1] = (f32x2){0.f, 0.f}; }
        u16 = unit * 16;
    }
    int u16;
    __device__ __forceinline__ void issue(int blk, Stg& s) const {
        blk = blk < NPB ? blk : NPB - 1;
#pragma unroll
        for (int i = 0; i < 2; ++i) { const h16* rp = base - u16 + (size_t)(blk * PB + (lane >> 4) + 4 * i) * NPROJ + (lane & 15) * 8; s.q[i] = *(const h16x8*)(rp + C_AQ); s.k[i] = *(const h16x8*)(rp + C_AF); }
        if (lane < 16) s.v = *(const h16x8*)(base + (size_t)(blk * PB + (lane >> 1)) * NPROJ + C_AI + (lane & 1) * 8);
    }
    __device__ __forceinline__ void write(const Stg& s, LAS float* slot) const {
#pragma unroll
        for (int i = 0; i < 2; ++i) { LAS float* d = slot + ((lane >> 4) + 4 * i) * REC + (lane & 15) * 8; cvt8(s.q[i], d); cvt8(s.k[i], d + 128); }
        if (lane < 16) cvt8(s.v, slot + (lane >> 1) * REC + 256 + (lane & 1) * 8);
    }
    struct In { f32x4 q0, q1, k0, k1, v4; };
    __device__ __forceinline__ void load(const LAS float* rec, In& x) const {
        x.q0 = *(const LAS f32x4*)(rec + 4 * seg); x.q1 = *(const LAS f32x4*)(rec + 64 + 4 * seg); x.k0 = *(const LAS f32x4*)(rec + 128 + 4 * seg); x.k1 = *(const LAS f32x4*)(rec + 192 + 4 * seg);
        x.v4 = *(const LAS f32x4*)(rec + 256 + 4 * cgp);
    }
    __device__ __forceinline__ void step(const In& x, int t) {
        const f32x4 q0 = x.q0, q1 = x.q1, k0 = x.k0, k1 = x.k1, v4 = x.v4;
        const f32x2 va = {v4[0], v4[1]}, vb = {v4[2], v4[3]};
        f32x2 oa = {0.f, 0.f}, obb = {0.f, 0.f};
#pragma unroll
        for (int r = 0; r < 8; ++r) { const float kk = r < 4 ? k0[r & 3] : k1[r & 3], qq = r < 4 ? q0[r & 3] : q1[r & 3];
            S[r][0] = S[r][0] + kk * (va - S[r][0]); S[r][1] = S[r][1] + kk * (vb - S[r][1]); oa = oa + S[r][0] * qq; obb = obb + S[r][1] * qq; }
        const f32x4 o = {red16(oa[0]), red16(oa[1]), red16(obb[0]), red16(obb[1])};
        const bool mine = seg == (t & (PB - 1));
        ko[0] = mine ? o[0] : ko[0]; ko[1] = mine ? o[1] : ko[1]; ko[2] = mine ? o[2] : ko[2]; ko[3] = mine ? o[3] : ko[3];
    }
    f32x4 ko;
    __device__ __forceinline__ void flush(int t0) { if (seg < PB) *(f32x4*)(ob + (size_t)(t0 + seg) * 1536) = ko; }
    __device__ __forceinline__ void finish(const P& p, int l, int b, int h, int unit) const {
        float* op = p.out + O_HA_P + (((size_t)l * 8 + b) * 4 + h) * 16384 + unit * 16 + cgp * 4;
#pragma unroll
        for (int r = 0; r < 8; ++r) { const int row = (r >> 2) * 64 + 4 * seg + (r & 3); *(f32x4*)(op + (size_t)row * 128) = (f32x4){S[r][0][0], S[r][0][1], S[r][1][0], S[r][1][1]}; }
    }
};
struct PScanC {
    static constexpr int REC = 268;
    struct Stg { h16x8 q[2], k[2], v; float beta, g; };
    const h16* base; const float* gt; int lane, seg, cgp, u8; f32x2 S[8]; float* ob;
    __device__ __forceinline__ void init(const P& p, int l, int b, int h, int unit, int lane_) {
        lane = lane_; seg = lane & 15; cgp = lane >> 4; u8 = unit * 8;
        base = (const h16*)(p.ws + WS_R1) + (size_t)b * 2048 * 1536 + h * 128; gt = (const float*)(p.ws + WS_G) + (size_t)b * 2048 * 16 + h;
        ob = (float*)(p.ws + WS_R2) + (size_t)b * 2048 * 1536 + 1024 + h * 128 + u8 + cgp * 2;
#pragma unroll
        for (int r = 0; r < 8; ++r) S[r] = (f32x2){0.f, 0.f};
    }
    __device__ __forceinline__ void issue(int blk, Stg& s) const {
        blk = blk < NPB ? blk : NPB - 1;
#pragma unroll
        for (int i = 0; i < 2; ++i) { const h16* rp = base + (size_t)(blk * PB + (lane >> 4) + 4 * i) * 1536 + (lane & 15) * 8; s.q[i] = *(const h16x8*)rp; s.k[i] = *(const h16x8*)(rp + 512); }
        if (lane < 8) { const size_t row = (size_t)(blk * PB + lane); s.v = *(const h16x8*)(base + row * 1536 + 1024 + u8); s.beta = gt[row * 16 + 8]; s.g = gt[row * 16 + 12]; }
    }
    __device__ __forceinline__ void write(const Stg& s, LAS float* slot) const {
#pragma unroll
        for (int i = 0; i < 2; ++i) { LAS float* d = slot + ((lane >> 4) + 4 * i) * REC + (lane & 15) * 8; cvt8(s.q[i], d); cvt8(s.k[i], d + 128); }
        if (lane < 8) { LAS float* d = slot + lane * REC + 256; cvt8(s.v, d); *(LAS f32x2*)(d + 8) = (f32x2){s.beta, __expf(s.g)}; }
    }
    struct In { f32x4 q0, q1, k0, k1; f32x2 v2, ba; };
    __device__ __forceinline__ void load(const LAS float* rec, In& x) const {
        x.q0 = *(const LAS f32x4*)(rec + 4 * seg); x.q1 = *(const LAS f32x4*)(rec + 64 + 4 * seg); x.k0 = *(const LAS f32x4*)(rec + 128 + 4 * seg); x.k1 = *(const LAS f32x4*)(rec + 192 + 4 * seg);
        x.v2 = *(const LAS f32x2*)(rec + 256 + 2 * cgp); x.ba = *(const LAS f32x2*)(rec + 264);
    }
    __device__ __forceinline__ void step(const In& x, int t) {
        const f32x4 q0 = x.q0, q1 = x.q1, k0 = x.k0, k1 = x.k1; const f32x2 v2 = x.v2, ba = x.ba;
        f32x2 u = {0.f, 0.f};
#pragma unroll
        for (int r = 0; r < 8; ++r) { const float kk = r < 4 ? k0[r & 3] : k1[r & 3]; u = u + S[r] * kk; }
        u[0] = red16(u[0]); u[1] = red16(u[1]);
        const float beta = ba[0], a = ba[1];
        const f32x2 vn = beta * (v2 - a * u);
        f32x2 o = {0.f, 0.f};
#pragma unroll
        for (int r = 0; r < 8; ++r) { const float kk = r < 4 ? k0[r & 3] : k1[r & 3], qq = r < 4 ? q0[r & 3] : q1[r & 3]; S[r] = a * S[r] + kk * vn; o = o + S[r] * qq; }
        o[0] = red16(o[0]); o[1] = red16(o[1]);
        const bool mine = seg == (t & (PB - 1));
        ko[0] = mine ? o[0] : ko[0]; ko[1] = mine ? o[1] : ko[1];
    }
    f32x2 ko;
    __device__ __forceinline__ void flush(int t0) { if (seg < PB) *(f32x2*)(ob + (size_t)(t0 + seg) * 1536) = ko; }
    __device__ __forceinline__ void finish(const P& p, int l, int b, int h, int unit) const {
        float* op = p.out + O_G_P + (((size_t)l * 8 + b) * 4 + h) * 16384 + u8 + cgp * 2;
#pragma unroll
        for (int r = 0; r < 8; ++r) { const int row = (r >> 2) * 64 + 4 * seg + (r & 3); *(f32x2*)(op + (size_t)row * 128) = S[r]; }
    }
};
struct PScanB {
    static constexpr int REC = 148;
    struct Stg { h16x8 q, k, v; float ig, lf; };
    const h16* base; const float* gt; int lane, seg, vg, u16; f32x2 C[4][2], nn[2]; float m; float* ob;
    __device__ __forceinline__ void init(const P& p, int l, int b, int h, int unit, int lane_) {
        lane = lane_; seg = lane & 15; vg = lane >> 4; u16 = unit * 16;
        base = (const h16*)(p.ws + WS_P) + (size_t)b * 2048 * NPROJ; gt = (const float*)(p.ws + WS_G) + (size_t)b * 2048 * 16 + h;
        hq = h * 64; hv = h * 128 + u16;
        ob = (float*)(p.ws + WS_R2) + (size_t)b * 2048 * 1536 + 512 + h * 128 + u16 + vg * 4;
#pragma unroll
        for (int i = 0; i < 4; ++i) { C[i][0] = (f32x2){0.f, 0.f}; C[i][1] = (f32x2){0.f, 0.f}; }
        nn[0] = (f32x2){0.f, 0.f}; nn[1] = (f32x2){0.f, 0.f}; m = 0.f;
    }
    int hq, hv;
    __device__ __forceinline__ void issue(int blk, Stg& s) const {
        blk = blk < NPB ? blk : NPB - 1;
        { const h16* rp = base + (size_t)(blk * PB + (lane >> 3)) * NPROJ + hq + (lane & 7) * 8; s.q = *(const h16x8*)(rp + C_BQ); s.k = *(const h16x8*)(rp + C_BK); }
        if (lane < 16) s.v = *(const h16x8*)(base + (size_t)(blk * PB + (lane >> 1)) * NPROJ + C_BV + hv + (lane & 1) * 8);
        if (lane < 8) { const size_t row = (size_t)(blk * PB + lane); s.ig = gt[row * 16]; s.lf = gt[row * 16 + 4]; }
    }
    __device__ __forceinline__ void write(const Stg& s, LAS float* slot) const {
        { LAS float* d = slot + (lane >> 3) * REC + (lane & 7) * 8; cvt8(s.q, d); cvt8(s.k, d + 64); }
        if (lane < 16) cvt8(s.v, slot + (lane >> 1) * REC + 128 + (lane & 1) * 8);
        if (lane < 8) *(LAS f32x2*)(slot + lane * REC + 144) = (f32x2){s.ig, s.lf};
    }
    struct In { f32x4 q4, k4, v4; f32x2 gl; };
    __device__ __forceinline__ void load(const LAS float* rec, In& x) const {
        x.q4 = *(const LAS f32x4*)(rec + 4 * seg); x.k4 = *(const LAS f32x4*)(rec + 64 + 4 * seg); x.v4 = *(const LAS f32x4*)(rec + 128 + 4 * vg); x.gl = *(const LAS f32x2*)(rec + 144);
    }
    __device__ __forceinline__ void step(const In& x, int t) {
        const f32x4 q4 = x.q4, k4 = x.k4, v4 = x.v4; const f32x2 gl = x.gl;
        const float ig = gl[0], lf = gl[1];
        const float mn = fmaxf(lf + m, ig), wo = __expf(lf + m - mn), wi = __expf(ig - mn); m = mn;
        const f32x2 ka = {k4[0], k4[1]}, kb = {k4[2], k4[3]}, qa = {q4[0], q4[1]}, qb = {q4[2], q4[3]};
        nn[0] = wo * nn[0] + wi * ka; nn[1] = wo * nn[1] + wi * kb;
        const f32x2 dd = nn[0] * qa + nn[1] * qb; float den = red16(dd[0] + dd[1]);
        f32x4 num;
#pragma unroll
        for (int i = 0; i < 4; ++i) { const float wv = wi * v4[i]; C[i][0] = wo * C[i][0] + wv * ka; C[i][1] = wo * C[i][1] + wv * kb; const f32x2 nd = C[i][0] * qa + C[i][1] * qb; num[i] = red16(nd[0] + nd[1]); }
        const float inv = __builtin_amdgcn_rcpf(fmaxf(fabsf(den), __expf(-m)));
        const bool mine = seg == (t & (PB - 1));
        ko[0] = mine ? num[0] * inv : ko[0]; ko[1] = mine ? num[1] * inv : ko[1]; ko[2] = mine ? num[2] * inv : ko[2]; ko[3] = mine ? num[3] * inv : ko[3];
    }
    f32x4 ko;
    __device__ __forceinline__ void flush(int t0) { if (seg < PB) *(f32x4*)(ob + (size_t)(t0 + seg) * 1536) = ko; }
    __device__ __forceinline__ void finish(const P& p, int l, int b, int h, int unit) const {
        const size_t bh = ((size_t)l * 8 + b) * 4 + h;
        float* op = p.out + O_MC_P + bh * 8192 + (size_t)(u16 + vg * 4) * 64 + 4 * seg;
#pragma unroll
        for (int i = 0; i < 4; ++i) *(f32x4*)(op + i * 64) = (f32x4){C[i][0][0], C[i][0][1], C[i][1][0], C[i][1][1]};
        if (unit == 0 && vg == 0) { *(f32x4*)(p.out + O_MN_P + bh * 64 + 4 * seg) = (f32x4){nn[0][0], nn[0][1], nn[1][0], nn[1][1]}; if (seg == 0) p.out[O_MM_P + bh] = m; }
    }
};
template <class Sc> __device__ __forceinline__ void run_pscan(const P& p, int l, int b, int h, int unit, int lane, LAS float* wl) {
    Sc sc; sc.init(p, l, b, h, unit, lane);
    LAS float* slot0 = wl; LAS float* slot1 = wl + 4096;
    typename Sc::Stg s0, s1;
    sc.issue(0, s0); sc.issue(1, s1);
    sc.write(s0, slot0); sc.issue(2, s0);
    typename Sc::In cur, nxt;
    sc.load(slot0, cur);
#pragma unroll 1
    for (int i = 0; i < NPB; i += 2) {
        sc.write(s1, slot1); sc.issue(i + 3, s1);
#pragma unroll 4
        for (int tk = 0; tk < PB; ++tk) { sc.load(tk + 1 < PB ? slot0 + (tk + 1) * Sc::REC : slot1, nxt); sc.step(cur, tk); cur = nxt; }
        sc.flush(i * PB);
        sc.write(s0, slot0); sc.issue(i + 4, s0);
#pragma unroll 4
        for (int tk = 0; tk < PB; ++tk) { sc.load(tk + 1 < PB ? slot1 + (tk + 1) * Sc::REC : slot0, nxt); sc.step(cur, tk); cur = nxt; }
        sc.flush((i + 1) * PB);
    }
    sc.finish(p, l, b, h, unit);
}

__device__ void phase_scan(const P& p, int l, LAS unsigned char* lds) {
    const int lane = my_tid() & 63, wv = my_tid() >> 6; const int G = my_grid();
    if (wv < 4) {
        LAS float* wl = (LAS float*)(lds + wv * 32768);
        for (int blk = my_bid(); blk < 256; blk += G) {
            const int bh = blk >> 3, sub = blk & 7, b = bh >> 2, h = bh & 3;
            if (wv == 0) run_pscan<PScanA>(p, l, b, h, sub, lane, wl);
            else if (wv == 1) run_pscan<PScanB>(p, l, b, h, sub, lane, wl);
            else run_pscan<PScanC>(p, l, b, h, sub * 2 + (wv - 2), lane, wl);
        }
    } else {
        for (int su = my_bid() + G * (wv - 4); su < 6144; su += 4 * G) {
            const int br = su / 2048, idx = su % 2048, bh = idx >> 2, unit = idx & 3;
            if (br == 0) scanA<8>(p, l, 1, bh >> 2, bh & 3, unit, lane);
            else if (br == 1) scanB<8>(p, l, 1, bh >> 2, bh & 3, unit, lane);
            else scanC<8>(p, l, 1, bh >> 2, bh & 3, unit, lane);
        }
    }
}

__device__ void phase_norm(const P& p, int l) {
    const int lane = my_tid() & 63, wv = my_tid() >> 6, seg = lane & 15, hg = lane >> 4;
    const h16* proj = (const h16*)(p.ws + WS_P); const float* ob = (const float*)(p.ws + WS_R2); h16* ys = (h16*)(p.ws + WS_R1);
    for (int r = my_bid() + my_grid() * wv; r < T; r += my_grid() * NWAVES) {
#pragma unroll
        for (int it = 0; it < 3; ++it) {
            const int c = hg * 128 + seg * 8;
            const float* op = ob + (size_t)r * 1536 + it * 512 + c; const f32x4 o0 = *(const f32x4*)op, o1 = *(const f32x4*)(op + 4);
            float ss = 0.f;
#pragma unroll
            for (int j = 0; j < 4; ++j) ss += o0[j] * o0[j] + o1[j] * o1[j];
            ss = red16(ss); const float rs = rsqrtf(ss * (1.0f / 128.0f) + 1e-6f);
            const h16x8 gt = *(const h16x8*)(proj + (size_t)r * NPROJ + (it == 0 ? C_AG : (it == 1 ? C_BO : C_CG)) + c);
            const float* gp = p.in[it == 0 ? I_ANG : (it == 1 ? I_BNG : I_CNG)] + l * 512 + c; const f32x4 g0 = *(const f32x4*)gp, g1 = *(const f32x4*)(gp + 4);
            h16x8 y;
#pragma unroll
            for (int j = 0; j < 4; ++j) { y[j] = (h16)(o0[j] * rs * g0[j] * (float)gt[j]); y[4 + j] = (h16)(o1[j] * rs * g1[j] * (float)gt[4 + j]); }
            *(h16x8*)(ys + ((size_t)it * T + r) * 512 + c) = y;
        }
    }
}

__device__ void phase_ln(const P& p, const float* g, const float* bta, float* dst32) {
    const int lane = my_tid() & 63, wv = my_tid() >> 6;
    const float* pre = (const float*)(p.ws + WS_R2); h16* hh = (h16*)(p.ws + WS_R1);
    for (int r = my_bid() + my_grid() * wv; r < T; r += my_grid() * NWAVES) {
        f32x4 x[4]; float s = 0.f;
#pragma unroll
        for (int i = 0; i < 4; ++i) { x[i] = *(const f32x4*)(pre + (size_t)r * DM + 256 * i + 4 * lane); s += (x[i][0] + x[i][1]) + (x[i][2] + x[i][3]); }
        const float mu = red64(s) * (1.0f / DM); float q = 0.f;
#pragma unroll
        for (int i = 0; i < 4; ++i) { x[i] -= mu; q += (x[i][0] * x[i][0] + x[i][1] * x[i][1]) + (x[i][2] * x[i][2] + x[i][3] * x[i][3]); }
        const float rstd = rsqrtf(red64(q) * (1.0f / DM) + 1e-5f);
#pragma unroll
        for (int i = 0; i < 4; ++i) { const int c = 256 * i + 4 * lane; const f32x4 y = x[i] * rstd * *(const f32x4*)(g + c) + *(const f32x4*)(bta + c);
            *(f32x4*)(dst32 + (size_t)r * DM + c) = y; h16x4 o; o[0] = (h16)y[0]; o[1] = (h16)y[1]; o[2] = (h16)y[2]; o[3] = (h16)y[3]; *(h16x4*)(hh + (size_t)r * DM + c) = o; }
    }
}

#define XB_TMO      128
#define XB_XCNT(j)  (256  + 64 * (j))
#define XB_XSUB(j)  (1280 + 64 * (j))
#define XB_XGEN(j)  (2304 + 64 * (j))
#define XB_TOP      3328
#define XB_TOPGEN   3392
#define XCD_BAR_WORDS 3456
#define XB_SPIN_CAP (1u << 20)
__device__ __forceinline__ unsigned xb_ld(unsigned* p)              { return __hip_atomic_load(p, __ATOMIC_RELAXED, __HIP_MEMORY_SCOPE_AGENT); }
__device__ __forceinline__ unsigned xb_add(unsigned* p, unsigned v) { return __hip_atomic_fetch_add(p, v, __ATOMIC_RELAXED, __HIP_MEMORY_SCOPE_AGENT); }
__device__ __forceinline__ unsigned xb_xcc_id() { return (unsigned)__builtin_amdgcn_s_getreg((3 << 11) | 20) & 0xFu; }
#define XB_SPIN(cond, bar) do { unsigned _sp = 0; while (cond) { __builtin_amdgcn_s_sleep(1); \
    if ((++_sp & 255u) == 0u) { if (xb_ld(&(bar)[XB_TMO])) break; if (_sp > XB_SPIN_CAP) { atomicAdd(&(bar)[XB_TMO], 1u); break; } } } } while (0)
struct XcdBarrier { unsigned* bar; unsigned x; volatile LAS unsigned* st; };
__device__ __forceinline__ XcdBarrier xcd_barrier_post(unsigned* bar, volatile LAS unsigned* st) {
    XcdBarrier b; b.bar = bar; b.x = xb_xcc_id(); b.st = st;
    if (threadIdx.x == 0) (void)xb_add(&bar[XB_XCNT(b.x)], 1u);
    return b;
}
__device__ __forceinline__ void xcd_barrier_complete(unsigned* bar, unsigned x, unsigned& nloc, unsigned& nx) {
    const unsigned G = gridDim.x * gridDim.y * gridDim.z;
    unsigned sum, cnt, mine, sp = 0u;
    for (;;) {
        sum = 0u; cnt = 0u; mine = 0u;
#pragma unroll
        for (unsigned j = 0; j < 16; ++j) { const unsigned c = xb_ld(&bar[XB_XCNT(j)]); sum += c; cnt += (c > 0u) ? 1u : 0u; mine = (j == x) ? c : mine; }
        if (sum == G) break;
        __builtin_amdgcn_s_sleep(1);
        if ((++sp & 255u) == 0u) { if (xb_ld(&bar[XB_TMO])) break; if (sp > XB_SPIN_CAP) { atomicAdd(&bar[XB_TMO], 1u); break; } }
    }
    nloc = mine > 0u ? mine : 1u; nx = cnt > 0u ? cnt : 1u;
}
__device__ __forceinline__ void xcd_barrier(const XcdBarrier& b) {
    asm volatile("s_waitcnt vmcnt(0)" ::: "memory");
    __syncthreads();
    if (threadIdx.x == 0) {
        unsigned* bar = b.bar;
        __builtin_amdgcn_s_waitcnt(0);
        unsigned nloc = b.st[0], nx = b.st[1];
        if (nloc == 0u) { xcd_barrier_complete(bar, b.x, nloc, nx); b.st[0] = nloc; b.st[1] = nx; }
        const unsigned old = xb_add(&bar[XB_XSUB(b.x)], 1u);
        const unsigned gen = old / nloc;
        if (old + 1u == (gen + 1u) * nloc) {
            __builtin_amdgcn_fence(__ATOMIC_RELEASE, "agent");
            asm volatile("s_waitcnt vmcnt(0)" ::: "memory");
            const unsigned og = xb_add(&bar[XB_TOP], 1u);
            const unsigned tg = og / nx;
            if (og + 1u == (tg + 1u) * nx) xb_add(&bar[XB_TOPGEN], 1u);
            else XB_SPIN(xb_ld(&bar[XB_TOPGEN]) == tg, bar);
            __builtin_amdgcn_fence(__ATOMIC_ACQUIRE, "agent");
            xb_add(&bar[XB_XGEN(b.x)], 1u);
            asm volatile("s_waitcnt vmcnt(0)" ::: "memory");
        } else {
            XB_SPIN(xb_ld(&bar[XB_XGEN(b.x)]) == gen, bar);
            __builtin_amdgcn_fence(__ATOMIC_ACQUIRE, "agent");
            asm volatile("s_waitcnt vmcnt(0)" ::: "memory");
        }
    }
    __syncthreads();
}

#define PHASE_FN __device__ __forceinline__
PHASE_FN void ph_gemm_in(const P& p, int l, LAS unsigned char* lds) {
    unsigned char* ws = p.ws;
    pg8::Gemm g{(const h16*)(ws + WS_R1), (const h16*)(ws + WS_WIN) + (size_t)l * NPROJ * DM, T, NPROJ, DM}; pg8::StaticOrder S; S.init(T, NPROJ, my_grid(), my_bid());
    EpiIn E{(h16*)(ws + WS_P), (float*)(ws + WS_G), (const float*)(ws + WS_LB) + l * 512, p.in[I_BMI] + l * 4, p.in[I_BMF] + l * 4, p.in[I_ALOG] + l * 4, p.in[I_DTB] + l * 4};
    pg8::gemm_phase(lds, g, S, E);
}
PHASE_FN void ph_gemm_br(const P& p, int l, LAS unsigned char* lds) {
    unsigned char* ws = p.ws;
    pg8::Gemm g{(const h16*)(ws + WS_R1), (const h16*)(ws + WS_WBR) + (size_t)l * 3072 * 512, 3 * T, 3072, 512}; pg8::BranchOrder S{my_grid(), my_bid()};
    EpiBranch E{(const h16*)(ws + WS_P), (h16*)(ws + WS_R2 + (size_t)T * DM * 4)};
    pg8::gemm_phase(lds, g, S, E);
    tail_branch((const h16*)(ws + WS_R1), (const h16*)(ws + WS_WBR) + (size_t)l * 3072 * 512, (const h16*)(ws + WS_P), (h16*)(ws + WS_R2 + (size_t)T * DM * 4));
}
PHASE_FN void ph_gemm_out(const P& p, int l, LAS unsigned char* lds) {
    unsigned char* ws = p.ws;
    pg8::Gemm g{(const h16*)(ws + WS_R2 + (size_t)T * DM * 4), (const h16*)(ws + WS_WOUT) + (size_t)l * DM * DM, TP, DM, DM}; pg8::StaticOrder S; S.init(TP, DM, my_grid(), my_bid());
    EpiRes E{(const float*)(ws + WS_H32), (float*)(ws + WS_R2)};
    pg8::gemm_phase(lds, g, S, E);
    tail_res(g.A, DM, g.Bt, E.h32, E.pre32);
}
PHASE_FN void ph_gemm_f1(const P& p, int l, LAS unsigned char* lds) {
    unsigned char* ws = p.ws;
    pg8::Gemm g{(const h16*)(ws + WS_R1), (const h16*)(ws + WS_WF1) + (size_t)l * 2 * FFH * DM, T, 2 * FFH, DM}; pg8::StaticOrder S; S.init(T, 2 * FFH, my_grid(), my_bid());
    EpiSwiglu E{(h16*)(ws + WS_P)};
    pg8::gemm_phase(lds, g, S, E);
}
PHASE_FN void ph_gemm_f2(const P& p, int l, LAS unsigned char* lds) {
    unsigned char* ws = p.ws;
    pg8::Gemm g{(const h16*)(ws + WS_P), (const h16*)(ws + WS_WF2) + (size_t)l * DM * FFH, TP, DM, FFH}; pg8::StaticOrder S; S.init(TP, DM, my_grid(), my_bid());
    EpiRes E{(const float*)(ws + WS_H32), (float*)(ws + WS_R2)};
    pg8::gemm_phase(lds, g, S, E);
    tail_res(g.A, FFH, g.Bt, E.h32, E.pre32);
}
PHASE_FN void ph_prep(const P& p, LAS unsigned char* lds) { phase_prep(p, lds); }
PHASE_FN void ph_conv(const P& p, int l) { phase_conv(p, l); }
PHASE_FN void ph_scan(const P& p, int l, LAS unsigned char* lds) { phase_scan(p, l, lds); }
PHASE_FN void ph_norm(const P& p, int l) { phase_norm(p, l); }
PHASE_FN void ph_ln(const P& p, int l, int which) {
    float* h32 = (float*)(p.ws + WS_H32);
    if (which == 0) phase_ln(p, p.in[I_L1G] + l * DM, p.in[I_L1B] + l * DM, h32);
    else phase_ln(p, p.in[I_L2G] + l * DM, p.in[I_L2B] + l * DM, l == DEPTH - 1 ? p.out + O_Y : h32);
}

template <int MASK> __global__ void __launch_bounds__(NTHREADS, 2) fwd_kernel(P p) {
    extern __shared__ __attribute__((aligned(16))) unsigned char lds_raw[];
    LAS unsigned char* lds = (LAS unsigned char*)lds_raw;
    volatile LAS unsigned* bst = (volatile LAS unsigned*)(lds + pg8::STAGE_BYTES);
    if (threadIdx.x == 0) { bst[0] = 0u; bst[1] = 0u; }
    __syncthreads();
    XcdBarrier xbar; xbar.bar = (unsigned*)(p.ws + WS_BAR); xbar.x = 0; xbar.st = bst;
    if (p.hi - p.lo > 1) xbar = xcd_barrier_post((unsigned*)(p.ws + WS_BAR), bst);
#define GRID_SYNC(ph_) do { if ((ph_) == 0) cg::this_grid().sync(); else xcd_barrier(xbar); } while (0)
    for (int e = 0; e < EXTRA_SYNCS; ++e) xcd_barrier(xbar);
    for (int ph2 = 2 * p.lo; ph2 < 2 * p.hi; ++ph2) {
        const int ph = ph2 >> 1;
        if (ph2 & 1) { const int kb = ph == 0 ? 0 : 1 + (ph - 1) % 10; if (!((DUP_MASK >> kb) & 1)) { if (ph + 1 < p.hi) GRID_SYNC(ph); continue; } GRID_SYNC(ph); }
        if (ph == 0) { if constexpr ((MASK & 1) != 0) ph_prep(p, lds); }
        else {
            const int l = (ph - 1) / 10, k = (ph - 1) % 10;
            switch (k) {
            case 0: if constexpr ((MASK & 2) != 0) ph_gemm_in(p, l, lds); break;
            case 1: if constexpr ((MASK & 4) != 0) ph_conv(p, l); break;
            case 2: if constexpr ((MASK & 8) != 0) ph_scan(p, l, lds); break;
            case 3: if constexpr ((MASK & 16) != 0) ph_norm(p, l); break;
            case 4: if constexpr ((MASK & 32) != 0) ph_gemm_br(p, l, lds); break;
            case 5: if constexpr ((MASK & 64) != 0) ph_gemm_out(p, l, lds); break;
            case 6: if constexpr ((MASK & 128) != 0) ph_ln(p, l, 0); break;
            case 7: if constexpr ((MASK & 256) != 0) ph_gemm_f1(p, l, lds); break;
            case 8: if constexpr ((MASK & 512) != 0) ph_gemm_f2(p, l, lds); break;
            default: if constexpr ((MASK & 1024) != 0) ph_ln(p, l, 1); break;
            }
        }
        if ((ph2 & 1) && ph + 1 < p.hi) GRID_SYNC(ph);
    }
}

constexpr int N_PHASES = 1 + 10 * DEPTH;
constexpr int LDS_BYTES = pg8::STAGE_BYTES + 16;
constexpr int MASK_ALL = 2047;

template <int MASK> static bool setup_k() { return hipFuncSetAttribute((const void*)fwd_kernel<MASK>, hipFuncAttributeMaxDynamicSharedMemorySize, LDS_BYTES) == hipSuccess; }
template <int MASK> static void launch_k(int grid, hipStream_t stream, const P& p) { hipLaunchKernelGGL(fwd_kernel<MASK>, dim3(grid), dim3(NTHREADS), LDS_BYTES, stream, p); }

extern "C" void kernel_launch(void* const* d_in, const int* in_sizes, int n_in, void* d_out, int out_size, void* d_ws, size_t ws_size, hipStream_t stream) {
    static int grid = 0;
    if (grid == 0) {
        if (n_in != 26 || (size_t)out_size != O_END || ws_size < WS_END) { fprintf(stderr, "kernel_launch: unexpected sizes n_in %d out %d ws %zu (need %zu)\n", n_in, out_size, ws_size, (size_t)WS_END); grid = -1; return; }
        int dev = 0, cus = 0, per_cu = 0;
        (void)hipGetDevice(&dev); (void)hipDeviceGetAttribute(&cus, hipDeviceAttributeMultiprocessorCount, dev);
#if N_LAUNCH_MODE == 1
        bool ok = setup_k<MASK_ALL>();
        if (ok && (hipOccupancyMaxActiveBlocksPerMultiprocessor(&per_cu, (const void*)fwd_kernel<MASK_ALL>, NTHREADS, LDS_BYTES) != hipSuccess || per_cu < 1)) { fprintf(stderr, "occupancy query: %d\n", per_cu); }
#else
        bool ok = setup_k<1>() && setup_k<2>() && setup_k<4>() && setup_k<8>() && setup_k<16>() && setup_k<32>() && setup_k<64>() && setup_k<128>() && setup_k<256>() && setup_k<512>() && setup_k<1024>();
#endif
        if (!ok) { fprintf(stderr, "hipFuncSetAttribute failed\n"); grid = -1; return; }
        (void)hipGetLastError();
        grid = cus;
    }
    if (grid < 0) return;
    P p{};
    for (int i = 0; i < 26; ++i) p.in[i] = (const float*)d_in[i];
    p.out = (float*)d_out; p.ws = (unsigned char*)d_ws;
#if N_LAUNCH_MODE == 1
    if (hipMemsetAsync((unsigned char*)d_ws + WS_BAR, 0, XCD_BAR_WORDS * 4, stream) != hipSuccess) { fprintf(stderr, "memset of barrier words failed\n"); return; }
    p.lo = 0; p.hi = N_PHASES;
    void* args[] = {&p};
    hipError_t e = hipLaunchCooperativeKernel((const void*)fwd_kernel<MASK_ALL>, dim3(grid), dim3(NTHREADS), args, LDS_BYTES, stream);
    if (e != hipSuccess) fprintf(stderr, "cooperative launch failed: %s (grid %d)\n", hipGetErrorString(e), grid);
#else
    for (int ph = 0; ph < N_PHASES; ++ph) {
        p.lo = ph; p.hi = ph + 1;
        const int k = ph == 0 ? 0 : 1 + (ph - 1) % 10;
        switch (k) {
        case 0: launch_k<1>(grid, stream, p); break;
        case 1: launch_k<2>(grid, stream, p); break;
        case 2: launch_k<4>(grid, stream, p); break;
        case 3: launch_k<8>(grid, stream, p); break;
        case 4: launch_k<16>(grid, stream, p); break;
        case 5: launch_k<32>(grid, stream, p); break;
        case 6: launch_k<64>(grid, stream, p); break;
        case 7: launch_k<128>(grid, stream, p); break;
        case 8: launch_k<256>(grid, stream, p); break;
        case 9: launch_k<512>(grid, stream, p); break;
        default: launch_k<1024>(grid, stream, p); break;
        }
    }
#endif
}
```
